# Optimizing an MI355X kernel written in HIP

```python
import jax, jax.numpy as jnp
from jax import lax
import numpy as np

D_MODEL = 1024
BATCH = 16
SEQ = 2048
DEPTH = 2

CTX_LEN = 256
GRID_W = 64
ROPE_THETA = 10000.0
NORM_EPS = 1e-6
ATTN_QBLK = 128

MLA_HEADS = 8
MLA_Q_RANK = 384
MLA_KV_RANK = 256
MLA_NOPE = 64
MLA_ROPE = 32
MLA_V = 64
SWA_HEADS = 8
SWA_KV_HEADS = 2
SWA_GROUP = SWA_HEADS // SWA_KV_HEADS
SWA_HEAD_DIM = 64
SWA_WINDOW = 128
SWA_BLK = SWA_WINDOW
DN_HEADS = 8
DN_HEAD_DIM = 64
DN_CONV = 5
DN_CHUNK = 64
N_BRANCH = 3
BRANCH_W = MLA_HEADS * MLA_V
N_EXPERTS = 32
TOP_K = 4
D_EXPERT = 1024
SWIGLU_LIMIT = 7.0
SWIGLU_ALPHA = 1.702
MOE_BLK = 256

IN_SIZES = (
    MLA_Q_RANK,
    MLA_KV_RANK,
    MLA_ROPE,
    SWA_HEADS * SWA_HEAD_DIM,
    SWA_KV_HEADS * SWA_HEAD_DIM,
    SWA_KV_HEADS * SWA_HEAD_DIM,
    3 * DN_HEADS * DN_HEAD_DIM,
    DN_HEADS * DN_HEAD_DIM,
    2 * DN_HEADS,
    2 * DN_HEADS,
    N_BRANCH * D_MODEL,
)
D_IN = sum(IN_SIZES)

kernel_name = "hybrid_mla_swa_deltanet_moe_dit"


def _rmsnorm(x, g):
    xf = x.astype(jnp.float32)
    y = xf * lax.rsqrt(jnp.mean(xf * xf, axis=-1, keepdims=True) + NORM_EPS)
    return (y * g.astype(jnp.float32)).astype(x.dtype)


def _l2norm(x):
    xf = x.astype(jnp.float32)
    return (xf * lax.rsqrt(jnp.sum(xf * xf, axis=-1, keepdims=True) + NORM_EPS)).astype(x.dtype)


def _modulate(h, shift, scale):
    return h * (1 + scale) + shift


def _split(x, sizes):
    return jnp.split(x, np.cumsum(sizes)[:-1].tolist(), axis=-1)


def _axial_rope_tables(n_tok, rot_dim):
    rows = n_tok // GRID_W
    row = jnp.broadcast_to(jnp.arange(rows)[:, None], (rows, GRID_W)).reshape(-1).astype(jnp.float32)
    col = jnp.broadcast_to(jnp.arange(GRID_W)[None, :], (rows, GRID_W)).reshape(-1).astype(jnp.float32)
    n_freq = rot_dim // 4
    inv_freq = ROPE_THETA ** (-jnp.arange(n_freq, dtype=jnp.float32) / n_freq)
    ang = jnp.concatenate([row[:, None] * inv_freq, col[:, None] * inv_freq], axis=-1)
    return jnp.cos(ang), jnp.sin(ang)


def _apply_rope(x, cos, sin):
    xf = x.astype(jnp.float32)
    x1, x2 = jnp.split(xf, 2, axis=-1)
    cs, sn = cos[None, :, None, :], sin[None, :, None, :]
    return jnp.concatenate([x1 * cs - x2 * sn, x2 * cs + x1 * sn], axis=-1).astype(x.dtype)


def _dense_block_attention(q, k, v, scale):
    B, S, H, dk = q.shape
    nb = S // ATTN_QBLK
    qb = jnp.moveaxis(q.reshape(B, nb, ATTN_QBLK, H, dk), 1, 0)

    def one(qblk):
        s = jnp.einsum('bqhd,bthd->bhqt', qblk, k).astype(jnp.float32) * scale
        p = jax.nn.softmax(s, axis=-1).astype(v.dtype)
        return jnp.einsum('bhqt,bthe->bqhe', p, v)

    o = lax.map(one, qb)
    return jnp.moveaxis(o, 0, 1).reshape(B, S, H, v.shape[-1])


def _mla_branch(cq, ckv, kr, cq_c, ckv_c, kr_c, q_norm_g, w_q_up, kv_norm_g, w_kv_up, cos, sin, ctx_out):
    scale = (MLA_NOPE + MLA_ROPE) ** -0.5

    def queries(cqx):
        B, T = cqx.shape[:2]
        return (_rmsnorm(cqx, q_norm_g) @ w_q_up).reshape(B, T, MLA_HEADS, MLA_NOPE + MLA_ROPE)

    def keys_values(ckvx, krx):
        B, T = ckvx.shape[:2]
        kv = (_rmsnorm(ckvx, kv_norm_g) @ w_kv_up).reshape(B, T, MLA_HEADS, MLA_NOPE + MLA_V)
        k_nope, v = kv[..., :MLA_NOPE], kv[..., MLA_NOPE:]
        k_rope = jnp.broadcast_to(krx, (B, T, MLA_HEADS, MLA_ROPE))
        return jnp.concatenate([k_nope, k_rope], axis=-1), v

    B, S = cq.shape[:2]
    q = queries(cq)
    q = jnp.concatenate([q[..., :MLA_NOPE], _apply_rope(q[..., MLA_NOPE:], cos, sin)], axis=-1)
    k, v = keys_values(ckv, _apply_rope(kr[:, :, None, :], cos, sin))
    kc, vc = keys_values(ckv_c, kr_c[:, :, None, :])
    o = _dense_block_attention(q, jnp.concatenate([kc, k], axis=1), jnp.concatenate([vc, v], axis=1), scale)
    o = o.reshape(B, S, BRANCH_W)
    if not ctx_out:
        return o, None
    oc = _dense_block_attention(queries(cq_c), kc, vc, scale)
    return o, oc.reshape(cq_c.shape[0], cq_c.shape[1], BRANCH_W)


def _sink_attend(q, segs, sink, scale):
    scores = []
    for k, _, m in segs:
        s = jnp.einsum('bqngd,btnd->bngqt', q, k).astype(jnp.float32) * scale
        if m is not None:
            s = jnp.where(m, s, -jnp.inf)
        scores.append(s)
    B, N, G, Q = scores[0].shape[:4]
    sink_col = jnp.broadcast_to(sink[None, :, :, None, None], (B, N, G, Q, 1))
    p = jax.nn.softmax(jnp.concatenate(scores + [sink_col], axis=-1), axis=-1)
    out = None
    off = 0
    for (k, v, _), s in zip(segs, scores):
        t = s.shape[-1]
        o = jnp.einsum('bngqt,btnd->bqngd', p[..., off:off + t].astype(v.dtype), v)
        out = o if out is None else out + o
        off += t
    return out


def _swa_branch(sq, sk, sv, sq_c, sk_c, sv_c, sink, cos, sin, ctx_out):
    B, S = sq.shape[:2]
    T = sq_c.shape[1]
    dh = SWA_HEAD_DIM
    scale = dh ** -0.5
    sink_g = sink.astype(jnp.float32).reshape(SWA_KV_HEADS, SWA_GROUP)
    q = _apply_rope(sq.reshape(B, S, SWA_HEADS, dh), cos, sin).reshape(B, S, SWA_KV_HEADS, SWA_GROUP, dh)
    k = _apply_rope(sk.reshape(B, S, SWA_KV_HEADS, dh), cos, sin)
    v = sv.reshape(B, S, SWA_KV_HEADS, dh)
    kc = sk_c.reshape(B, T, SWA_KV_HEADS, dh)
    vc = sv_c.reshape(B, T, SWA_KV_HEADS, dh)
    pad = ((0, 0), (SWA_WINDOW, SWA_WINDOW), (0, 0), (0, 0))
    kpad, vpad = jnp.pad(k, pad), jnp.pad(v, pad)
    rel = (jnp.arange(3 * SWA_BLK) - SWA_BLK)[None, :] - jnp.arange(SWA_BLK)[:, None]
    band = jnp.abs(rel) <= SWA_WINDOW

    def block(i):
        start = i * SWA_BLK
        qb = lax.dynamic_slice_in_dim(q, start, SWA_BLK, 1)
        kb = lax.dynamic_slice_in_dim(kpad, start, 3 * SWA_BLK, 1)
        vb = lax.dynamic_slice_in_dim(vpad, start, 3 * SWA_BLK, 1)
        kpos = start - SWA_BLK + jnp.arange(3 * SWA_BLK)
        mask = band & ((kpos >= 0) & (kpos < S))[None, :]
        return _sink_attend(qb, [(kc, vc, None), (kb, vb, mask)], sink_g, scale)

    o = lax.map(block, jnp.arange(S // SWA_BLK))
    o = jnp.moveaxis(o, 0, 1).reshape(B, S, BRANCH_W)
    if not ctx_out:
        return o, None
    qc = sq_c.reshape(B, T, SWA_KV_HEADS, SWA_GROUP, dh)
    oc = _sink_attend(qc, [(kc, vc, None)], sink_g, scale).reshape(B, T, BRANCH_W)
    return o, oc


def _short_conv(u, w):
    C = u.shape[-1]
    y = lax.conv_general_dilated(u, w[:, None, :].astype(u.dtype), window_strides=(1,),
                                 padding=[(DN_CONV // 2, DN_CONV // 2)],
                                 dimension_numbers=('NWC', 'WIO', 'NWC'), feature_group_count=C)
    return jax.nn.silu(y)


def _gated_delta_chunked(q, k, v, g, beta, s0, with_output):
    out_dtype = v.dtype
    B, T, H, dk = q.shape
    dv = v.shape[-1]
    C = DN_CHUNK
    n = T // C

    def chunks(x):
        x = x.astype(jnp.float32).reshape((B, n, C, H) + x.shape[3:])
        return jnp.moveaxis(x, 3, 2)

    q, k, v, g, beta = chunks(q), chunks(k), chunks(v), chunks(g), chunks(beta)
    gcum = jnp.cumsum(g, axis=-1)
    causal = jnp.tril(jnp.ones((C, C), bool))
    strict = jnp.tril(jnp.ones((C, C), bool), -1)
    diff = gcum[..., :, None] - gcum[..., None, :]
    decay = jnp.where(causal, jnp.exp(jnp.where(causal, diff, 0.0)), 0.0)
    kb = k * beta[..., None]
    lmat = jnp.where(strict, jnp.einsum('bnhid,bnhjd->bnhij', kb, k) * decay, 0.0)
    amat = lmat + jnp.eye(C, dtype=jnp.float32)
    rhs = jnp.concatenate([v * beta[..., None], kb * jnp.exp(gcum)[..., None]], axis=-1)
    sol = lax.linalg.triangular_solve(amat, rhs, left_side=True, lower=True, unit_diagonal=True)
    u, w = sol[..., :dv], sol[..., dv:]
    k_dec = k * jnp.exp(gcum[..., -1:] - gcum)[..., None]
    g_last = jnp.exp(gcum[..., -1])
    to_scan = lambda x: jnp.moveaxis(x, 1, 0)

    def state_update(S, w_i, u_i, kd_i, gl_i):
        v_new = u_i - jnp.einsum('bhck,bhkv->bhcv', w_i, S)
        S_next = S * gl_i[..., None, None] + jnp.einsum('bhck,bhcv->bhkv', kd_i, v_new)
        return S_next, v_new

    if not with_output:
        def step_state(S, xs):
            S_next, _ = state_update(S, *xs)
            return S_next, None
        s_fin, _ = lax.scan(step_state, s0, tuple(map(to_scan, (w, u, k_dec, g_last))))
        return s_fin, None

    a_intra = jnp.einsum('bnhid,bnhjd->bnhij', q, k) * decay
    q_dec = q * jnp.exp(gcum)[..., None]

    def step(S, xs):
        w_i, u_i, kd_i, gl_i, qd_i, a_i = xs
        S_next, v_new = state_update(S, w_i, u_i, kd_i, gl_i)
        o = jnp.einsum('bhck,bhkv->bhcv', qd_i, S) + jnp.einsum('bhij,bhjv->bhiv', a_i, v_new)
        return S_next, o

    s_fin, o = lax.scan(step, s0, tuple(map(to_scan, (w, u, k_dec, g_last, q_dec, a_intra))))
    o = jnp.moveaxis(jnp.moveaxis(o, 0, 1), 2, 3).reshape(B, T, H, dv).astype(out_dtype)
    return s_fin, o


def _deltanet_branch(dqkv, dz, dbeta, da, dqkv_c, dz_c, dbeta_c, da_c, conv_w, a_log, dt_bias, norm_g, ctx_out):
    H, dk = DN_HEADS, DN_HEAD_DIM

    def heads(u):
        B, T = u.shape[:2]
        q, k, v = jnp.split(_short_conv(u, conv_w), 3, axis=-1)
        q = _l2norm(q.reshape(B, T, H, dk)) * (dk ** -0.5)
        k = _l2norm(k.reshape(B, T, H, dk))
        return q, k, v.reshape(B, T, H, dk)

    def gates(braw, araw, d):
        beta = jax.nn.sigmoid(braw[..., d * H:(d + 1) * H].astype(jnp.float32))
        g = -jnp.exp(a_log[d].astype(jnp.float32)) * jax.nn.softplus(
            araw[..., d * H:(d + 1) * H].astype(jnp.float32) + dt_bias[d].astype(jnp.float32))
        return g, beta

    def out_gate(o, z):
        B, T = o.shape[:2]
        return (_rmsnorm(o, norm_g) * jax.nn.silu(z.reshape(B, T, H, dk))).reshape(B, T, H * dk)

    q, k, v = heads(dqkv)
    qc, kc, vc = heads(dqkv_c)
    s0 = jnp.zeros((q.shape[0], H, dk, dk), jnp.float32)
    o, oc = None, None
    for d in range(2):
        g, beta = gates(dbeta, da, d)
        g_c, beta_c = gates(dbeta_c, da_c, d)
        seq, cseq = (q, k, v, g, beta), (qc, kc, vc, g_c, beta_c)
        if d == 1:
            seq = tuple(jnp.flip(t, axis=1) for t in seq)
            cseq = tuple(jnp.flip(t, axis=1) for t in cseq)
        s_ctx, oc_d = _gated_delta_chunked(*cseq, s0, with_output=ctx_out)
        _, o_d = _gated_delta_chunked(*seq, s_ctx, with_output=True)
        if d == 1:
            o_d = jnp.flip(o_d, axis=1)
            oc_d = jnp.flip(oc_d, axis=1) if ctx_out else None
        o = o_d if o is None else o + o_d
        if ctx_out:
            oc = oc_d if oc is None else oc + oc_d
    o = out_gate(o, dz)
    return o, (out_gate(oc, dz_c) if ctx_out else None)


def _merge(branches, gate_raw, w_branch, w_out):
    gate_parts = jnp.split(gate_raw, N_BRANCH, axis=-1)
    y = None
    for i in range(N_BRANCH):
        yi = jax.nn.sigmoid(gate_parts[i]) * (branches[i] @ w_branch[i])
        y = yi if y is None else y + yi
    return y @ w_out


def _hybrid_mixer(h, hc, w_in, mla_q_norm_g, mla_w_q_up, mla_kv_norm_g, mla_w_kv_up, swa_sink,
                  dn_conv_w, dn_a_log, dn_dt_bias, dn_norm_g, w_branch, w_out, ctx_out):
    S = h.shape[1]
    cos_m, sin_m = _axial_rope_tables(S, MLA_ROPE)
    cos_s, sin_s = _axial_rope_tables(S, SWA_HEAD_DIM)
    cq, ckv, kr, sq, sk, sv, dqkv, dz, dbeta, da, gate_raw = _split(h @ w_in, IN_SIZES)
    cq_c, ckv_c, kr_c, sq_c, sk_c, sv_c, dqkv_c, dz_c, dbeta_c, da_c, gate_raw_c = _split(hc @ w_in, IN_SIZES)
    o_a, oc_a = _mla_branch(cq, ckv, kr, cq_c, ckv_c, kr_c, mla_q_norm_g, mla_w_q_up, mla_kv_norm_g,
                            mla_w_kv_up, cos_m, sin_m, ctx_out)
    o_b, oc_b = _swa_branch(sq, sk, sv, sq_c, sk_c, sv_c, swa_sink, cos_s, sin_s, ctx_out)
    o_c, oc_c = _deltanet_branch(dqkv, dz, dbeta, da, dqkv_c, dz_c, dbeta_c, da_c, dn_conv_w, dn_a_log,
                                 dn_dt_bias, dn_norm_g, ctx_out)
    y = _merge((o_a, o_b, o_c), gate_raw, w_branch, w_out)
    yc = _merge((oc_a, oc_b, oc_c), gate_raw_c, w_branch, w_out) if ctx_out else None
    return y, yc


def _moe_ffn(h, router_w, router_b, w_gu, b_gu, w_dn, b_dn):
    N, D = h.shape
    logits = (h @ router_w).astype(jnp.float32) + router_b.astype(jnp.float32)
    top_v, top_e = lax.top_k(logits, TOP_K)
    gate = jax.nn.softmax(top_v, axis=-1)
    A = N * TOP_K
    flat_e = top_e.reshape(A)
    order = jnp.argsort(flat_e)
    e_sorted = flat_e[order]
    tok_sorted = (order // TOP_K).astype(jnp.int32)
    gate_sorted = gate.reshape(A)[order]
    counts = jnp.zeros((N_EXPERTS,), jnp.int32).at[flat_e].add(1)
    padded = (counts + MOE_BLK - 1) // MOE_BLK * MOE_BLK
    pad_end = jnp.cumsum(padded)
    pad_start = pad_end - padded
    cnt_start = jnp.cumsum(counts) - counts
    slot = pad_start[e_sorted] + jnp.arange(A, dtype=jnp.int32) - cnt_start[e_sorted]
    n_blocks = -(-A // MOE_BLK) + N_EXPERTS
    P = n_blocks * MOE_BLK
    slot_tok = jnp.full((P,), N, jnp.int32).at[slot].set(tok_sorted)
    slot_gate = jnp.zeros((P,), jnp.float32).at[slot].set(gate_sorted)
    block_e = jnp.minimum(jnp.searchsorted(pad_end, jnp.arange(n_blocks, dtype=jnp.int32) * MOE_BLK, side='right'),
                          N_EXPERTS - 1)
    h_pad = jnp.concatenate([h, jnp.zeros((1, D), h.dtype)], axis=0)

    def run(args):
        idx, e = args
        xb = h_pad[idx]
        gu = xb @ w_gu[e] + b_gu[e]
        g_, u_ = gu[:, 0::2], gu[:, 1::2]
        g_ = jnp.minimum(g_, SWIGLU_LIMIT)
        u_ = jnp.clip(u_, -SWIGLU_LIMIT, SWIGLU_LIMIT)
        act = (u_ + 1) * (g_ * jax.nn.sigmoid(SWIGLU_ALPHA * g_))
        return act @ w_dn[e] + b_dn[e]

    yb = lax.map(run, (slot_tok.reshape(n_blocks, MOE_BLK), block_e)).reshape(P, D)
    y = jnp.zeros((N + 1, D), h.dtype).at[slot_tok].add(yb * slot_gate[:, None].astype(yb.dtype))
    return y[:N]


def setup_inputs(seed: int = 0) -> dict:
    key = jax.random.key(seed)
    ks = jax.random.split(key, 32)
    f32 = jnp.float32
    L, D, E, F, H = DEPTH, D_MODEL, N_EXPERTS, D_EXPERT, DN_HEADS

    def nrm(i, shape, scale):
        return jax.random.normal(ks[i], shape, f32) * scale

    def gain(i, shape):
        return 1.0 + nrm(i, shape, 0.02)

    dt = jnp.exp(jax.random.uniform(ks[16], (L, 2, H), f32, float(np.log(1e-3)), float(np.log(1e-1))))
    return {
        "x": nrm(0, (BATCH, SEQ, D), 1.0),
        "c": nrm(1, (BATCH, D), 1.0),
        "ctx": nrm(2, (BATCH, CTX_LEN, D), 1.0),
        "c_ctx": nrm(3, (D,), 1.0),
        "w_mod": nrm(4, (L, D, 6 * D), 0.5 * D ** -0.5),
        "b_mod": nrm(5, (L, 6 * D), 0.01),
        "norm1_g": gain(6, (L, D)),
        "norm2_g": gain(7, (L, D)),
        "w_in": nrm(8, (L, D, D_IN), D ** -0.5),
        "mla_q_norm_g": gain(9, (L, MLA_Q_RANK)),
        "mla_w_q_up": nrm(10, (L, MLA_Q_RANK, MLA_HEADS * (MLA_NOPE + MLA_ROPE)), MLA_Q_RANK ** -0.5),
        "mla_kv_norm_g": gain(11, (L, MLA_KV_RANK)),
        "mla_w_kv_up": nrm(12, (L, MLA_KV_RANK, MLA_HEADS * (MLA_NOPE + MLA_V)), MLA_KV_RANK ** -0.5),
        "swa_sink": nrm(13, (L, SWA_HEADS), 0.5),
        "dn_conv_w": nrm(14, (L, DN_CONV, 3 * DN_HEADS * DN_HEAD_DIM), DN_CONV ** -0.5),
        "dn_a_log": jnp.log(jax.random.uniform(ks[15], (L, 2, H), f32, 1.0, 8.0)),
        "dn_dt_bias": dt + jnp.log(-jnp.expm1(-dt)),
        "dn_norm_g": gain(17, (L, DN_HEAD_DIM)),
        "w_branch": nrm(18, (L, N_BRANCH, BRANCH_W, D), BRANCH_W ** -0.5),
        "w_out": nrm(19, (L, D, D), D ** -0.5),
        "router_w": nrm(20, (L, D, E), D ** -0.5),
        "router_b": nrm(21, (L, E), 0.01),
        "exp_w_gu": nrm(22, (L, E, D, 2 * F), D ** -0.5),
        "exp_b_gu": nrm(23, (L, E, 2 * F), 0.01),
        "exp_w_dn": nrm(24, (L, E, F, D), F ** -0.5),
        "exp_b_dn": nrm(25, (L, E, D), 0.01),
        "final_norm_g": gain(26, (D,)),
    }


def reference(x, c, ctx, c_ctx, w_mod, b_mod, norm1_g, norm2_g, w_in, mla_q_norm_g, mla_w_q_up,
              mla_kv_norm_g, mla_w_kv_up, swa_sink, dn_conv_w, dn_a_log, dn_dt_bias, dn_norm_g,
              w_branch, w_out, router_w, router_b, exp_w_gu, exp_b_gu, exp_w_dn, exp_b_dn, final_norm_g):
    B, S, D = x.shape
    T = ctx.shape[1]
    for l in range(DEPTH):
        last = l == DEPTH - 1
        mod = jax.nn.silu(c) @ w_mod[l] + b_mod[l]
        mod_c = jax.nn.silu(c_ctx) @ w_mod[l] + b_mod[l]
        sh1, sc1, g1, sh2, sc2, g2 = [m[:, None, :] for m in jnp.split(mod, 6, axis=-1)]
        sh1c, sc1c, g1c, sh2c, sc2c, g2c = jnp.split(mod_c, 6, axis=-1)

        h = _modulate(_rmsnorm(x, norm1_g[l]), sh1, sc1)
        hc = _modulate(_rmsnorm(ctx, norm1_g[l]), sh1c, sc1c)
        y, yc = _hybrid_mixer(h, hc, w_in[l], mla_q_norm_g[l], mla_w_q_up[l], mla_kv_norm_g[l], mla_w_kv_up[l],
                              swa_sink[l], dn_conv_w[l], dn_a_log[l], dn_dt_bias[l], dn_norm_g[l],
                              w_branch[l], w_out[l], ctx_out=not last)
        x = x + g1 * y
        h = _modulate(_rmsnorm(x, norm2_g[l]), sh2, sc2)
        moe_p = (router_w[l], router_b[l], exp_w_gu[l], exp_b_gu[l], exp_w_dn[l], exp_b_dn[l])
        if last:
            x = x + g2 * _moe_ffn(h.reshape(B * S, D), *moe_p).reshape(B, S, D)
        else:
            ctx = ctx + g1c * yc
            hc = _modulate(_rmsnorm(ctx, norm2_g[l]), sh2c, sc2c)
            f = _moe_ffn(jnp.concatenate([h.reshape(B * S, D), hc.reshape(B * T, D)], axis=0), *moe_p)
            x = x + g2 * f[:B * S].reshape(B, S, D)
            ctx = ctx + g2c * f[B * S:].reshape(B, T, D)
    return _rmsnorm(x, final_norm_g)
```

```cpp
#include <hip/hip_runtime.h>
#include <cstdint>
#include <cstdio>

typedef unsigned short bf16;
constexpr int D = 1024, NB = 16, SEQ = 2048, CTXL = 256, NLAT = NB * SEQ, NCTX = NB * CTXL, NTOK = NLAT + NCTX;
constexpr int DIN = 6592, LDP = 6656;
constexpr int C_CQ = 0, C_CKV = 384, C_KR = 640, C_SQ = 672, C_SK = 1184, C_SV = 1312, C_DQKV = 1440, C_DZ = 2976, C_DBETA = 3488, C_DA = 3504, C_GATE = 3520;
constexpr int NEXP = 32, TOPK = 4, DEXP = 1024;
constexpr int MAXSLOT = NTOK * TOPK + NEXP * 256;
constexpr float EPS = 1e-6f;

constexpr size_t MiB = 1u << 20;
constexpr size_t WS_CTL = 0, CTL_BYTES = 1 * MiB;
constexpr size_t WS_MOD = 1 * MiB, WS_RQ = 2 * MiB, WS_RKV = 2 * MiB + 512 * 1024, WS_DG = 3 * MiB, WS_DB = 6 * MiB;
constexpr size_t WS_TOPE = 9 * MiB, WS_TOPG = 10 * MiB, WS_TOPP = 11 * MiB, WS_LIST = 12 * MiB;
constexpr size_t WS_WIN = 17 * MiB, WS_WQUP = 43 * MiB, WS_WKVUP = 45 * MiB, WS_WBR = 46 * MiB, WS_WOUT = 52 * MiB, WS_WGU = 56 * MiB, WS_WDN = 184 * MiB;
constexpr size_t WS_XB = 248 * MiB, WS_H = 392 * MiB, WS_YB = 464 * MiB;
constexpr size_t WS_P = 536 * MiB, WS_QM = 1004 * MiB, WS_KM = 1058 * MiB, WS_VM = 1112 * MiB, WS_QS = 1148 * MiB, WS_KS = 1184 * MiB;
constexpr size_t WS_ACT = 536 * MiB, WS_YM = 840 * MiB;
constexpr size_t WS_DQ = 1193 * MiB, WS_DK = 1229 * MiB, WS_DV = 1265 * MiB, WS_DO = 1301 * MiB, WS_BR = 1445 * MiB, WS_PREP = 1553 * MiB, WS_YF = 1553 * MiB;
constexpr size_t WS_END = 1913 * MiB;
static_assert(WS_YM + (size_t)MAXSLOT * 1024 * 2 <= WS_DQ, "moe overlay");
constexpr int CW_CNT = 64;
constexpr int CW_BAR = 4096;

__device__ __forceinline__ float bf2f(bf16 v) { return __uint_as_float(((unsigned)v) << 16); }
__device__ __forceinline__ bf16 f2bf(float f) { unsigned u = __float_as_uint(f); return (bf16)((u + 0x7fffu + ((u >> 16) & 1u)) >> 16); }
__device__ __forceinline__ unsigned pk2(float lo, float hi) { return (unsigned)f2bf(lo) | ((unsigned)f2bf(hi) << 16); }
__device__ __forceinline__ float wave_sum(float v) {
#pragma unroll
    for (int o = 1; o < 64; o <<= 1) v += __shfl_xor(v, o);
    return v;
}
__device__ __forceinline__ float sigmoidf_(float x) { return __builtin_amdgcn_rcpf(1.f + __builtin_amdgcn_exp2f(-1.4426950408889634f * x)); }
__device__ __forceinline__ float siluf_(float x) { return x * __builtin_amdgcn_rcpf(1.f + __builtin_amdgcn_exp2f(-1.4426950408889634f * x)); }
__device__ __forceinline__ float softplusf_(float x) { return x > 20.f ? x : log1pf(__expf(x)); }
__device__ __forceinline__ int mod_row(int row) { return row < NLAT ? row / SEQ : NB; }

struct Ptrs {
    const float *x, *c, *ctx, *c_ctx, *w_mod, *b_mod, *norm1_g, *norm2_g, *w_in, *q_norm_g, *w_q_up, *kv_norm_g, *w_kv_up, *sink, *conv_w, *a_log, *dt_bias, *dn_norm_g,
        *w_branch, *w_out, *router_w, *router_b, *w_gu, *b_gu, *w_dn, *b_dn, *final_g;
    float* out; unsigned char* ws;
};

__global__ void k_mod(Ptrs p) {
    const int n = blockIdx.x * 256 + threadIdx.x, r = blockIdx.y, l = blockIdx.z;
    const float* cv = r < NB ? p.c + (size_t)r * D : p.c_ctx;
    const float* w = p.w_mod + (size_t)l * D * 6 * D;
    float acc = 0.f;
    for (int k = 0; k < D; ++k) acc += siluf_(cv[k]) * w[(size_t)k * 6 * D + n];
    ((float*)(p.ws + WS_MOD))[((size_t)l * 17 + r) * 6 * D + n] = acc + p.b_mod[(size_t)l * 6 * D + n];
}

__device__ __forceinline__ const float* xrow_src(const Ptrs& p, int l, int row) {
    if (l == 0) return row < NLAT ? p.x + (size_t)row * D : p.ctx + (size_t)(row - NLAT) * D;
    return (const float*)(p.ws + WS_XB) + (size_t)row * D;
}

__global__ __launch_bounds__(256) void k_norm1(Ptrs p, int l, int nrows, int mode) {
    const int lane = threadIdx.x & 63, row = blockIdx.x * 4 + (threadIdx.x >> 6);
    if (row >= nrows) return;
    const bool combine = (l > 0);
    const float* src = xrow_src(p, l == 2 ? 1 : l, row);
    if (l == 2) src = (const float*)(p.ws + WS_XB) + (size_t)row * D;
    float v[16];
#pragma unroll
    for (int j = 0; j < 4; ++j) { const float4 t = *(const float4*)(src + j * 256 + lane * 4); v[4 * j] = t.x; v[4 * j + 1] = t.y; v[4 * j + 2] = t.z; v[4 * j + 3] = t.w; }
    if (combine) {
        const int lp = l - 1;
        const float* modv = (const float*)(p.ws + WS_MOD) + ((size_t)lp * 17 + mod_row(row)) * 6 * D + 5 * D;
        const int* tope = (const int*)(p.ws + WS_TOPE) + (size_t)row * 4; const int* topp = (const int*)(p.ws + WS_TOPP) + (size_t)row * 4;
        const float* topg = (const float*)(p.ws + WS_TOPG) + (size_t)row * 4;
        const unsigned* cnt = (const unsigned*)(p.ws + WS_CTL) + CW_CNT + 32 * lp;
        float m[16];
#pragma unroll
        for (int i = 0; i < 16; ++i) m[i] = 0.f;
        for (int k = 0; k < 4; ++k) {
            const int e = tope[k]; int ps = 0;
            for (int e2 = 0; e2 < e; ++e2) ps += (int)((cnt[e2] + 255u) & ~255u);
            const bf16* y = (const bf16*)(p.ws + WS_YM) + (size_t)(ps + topp[k]) * D; const float g = topg[k];
#pragma unroll
            for (int j = 0; j < 4; ++j) { const uint2 t = *(const uint2*)(y + j * 256 + lane * 4);
                m[4 * j] += g * bf2f((bf16)(t.x & 0xffff)); m[4 * j + 1] += g * bf2f((bf16)(t.x >> 16)); m[4 * j + 2] += g * bf2f((bf16)(t.y & 0xffff)); m[4 * j + 3] += g * bf2f((bf16)(t.y >> 16)); }
        }
#pragma unroll
        for (int j = 0; j < 4; ++j)
#pragma unroll
            for (int i = 0; i < 4; ++i) v[4 * j + i] += modv[j * 256 + lane * 4 + i] * m[4 * j + i];
        if (mode != 2) { float* xb = (float*)(p.ws + WS_XB) + (size_t)row * D;
#pragma unroll
            for (int j = 0; j < 4; ++j) *(float4*)(xb + j * 256 + lane * 4) = make_float4(v[4 * j], v[4 * j + 1], v[4 * j + 2], v[4 * j + 3]); }
    }
    float s = 0.f;
#pragma unroll
    for (int i = 0; i < 16; ++i) s += v[i] * v[i];
    const float r = rsqrtf(wave_sum(s) * (1.f / D) + EPS);
    if (mode == 2) {
        float* o = p.out + (size_t)row * D;
#pragma unroll
        for (int j = 0; j < 4; ++j) { const float4 g = *(const float4*)(p.final_g + j * 256 + lane * 4);
            *(float4*)(o + j * 256 + lane * 4) = make_float4(v[4 * j] * r * g.x, v[4 * j + 1] * r * g.y, v[4 * j + 2] * r * g.z, v[4 * j + 3] * r * g.w); }
        return;
    }
    const float* ng = p.norm1_g + (size_t)l * D;
    const float* modv = (const float*)(p.ws + WS_MOD) + ((size_t)l * 17 + mod_row(row)) * 6 * D;
    bf16* h = (bf16*)(p.ws + WS_H) + (size_t)row * D;
#pragma unroll
    for (int j = 0; j < 4; ++j) { float o[4];
#pragma unroll
        for (int i = 0; i < 4; ++i) { const int c = j * 256 + lane * 4 + i; o[i] = v[4 * j + i] * r * ng[c] * (1.f + modv[D + c]) + modv[c]; }
        *(uint2*)(h + j * 256 + lane * 4) = make_uint2(pk2(o[0], o[1]), pk2(o[2], o[3])); }
}

template <class AF, class WF, class EF>
__device__ __forceinline__ void sgemm_tile(int M, int N, int K, int tm, int tn, const AF& af, const WF& wf, const EF& ef, float (*As)[132], float (*Ws)[132]) {
    const int tx = threadIdx.x & 15, ty = threadIdx.x >> 4;
    float acc[8][8];
#pragma unroll
    for (int i = 0; i < 8; ++i)
#pragma unroll
        for (int j = 0; j < 8; ++j) acc[i][j] = 0.f;
    for (int k0 = 0; k0 < K; k0 += 16) {
#pragma unroll
        for (int j = 0; j < 8; ++j) { const int e = threadIdx.x + 256 * j; const int r = e >> 4, kk = e & 15; As[kk][r] = (tm + r < M) ? af(tm + r, k0 + kk) : 0.f; }
#pragma unroll
        for (int j = 0; j < 8; ++j) { const int e = threadIdx.x + 256 * j; const int kk = e >> 7, n = e & 127; Ws[kk][n] = (tn + n < N) ? wf(k0 + kk, tn + n) : 0.f; }
        __syncthreads();
#pragma unroll
        for (int kk = 0; kk < 16; ++kk) {
            float a[8], w[8];
#pragma unroll
            for (int i = 0; i < 8; ++i) a[i] = As[kk][ty * 8 + i];
#pragma unroll
            for (int j = 0; j < 8; ++j) w[j] = Ws[kk][tx * 8 + j];
#pragma unroll
            for (int i = 0; i < 8; ++i)
#pragma unroll
                for (int j = 0; j < 8; ++j) acc[i][j] = fmaf(a[i], w[j], acc[i][j]);
        }
        __syncthreads();
    }
#pragma unroll
    for (int i = 0; i < 8; ++i) { const int m = tm + ty * 8 + i; if (m < M && tn + tx * 8 < N) ef(m, tn + tx * 8, acc[i]); }
}
template <class AF, class WF, class EF>
__global__ __launch_bounds__(256) void k_sgemm(int M, int N, int K, AF af, WF wf, EF ef) {
    __shared__ float As[16][132], Ws[16][132];
    sgemm_tile(M, N, K, blockIdx.y * 128, blockIdx.x * 128, af, wf, ef, As, Ws);
}
struct ABf { const bf16* A; int lda, pad; __device__ float operator()(int m, int k) const { return bf2f(A[(size_t)m * lda + k]); } };
struct ABfG { const bf16* A; const float* g; int lda, pad; __device__ float operator()(int m, int k) const { return bf2f(A[(size_t)m * lda + k]) * g[k]; } };
struct WF32 { const float* W; int ldw, pad; __device__ float operator()(int k, int n) const { return W[(size_t)k * ldw + n]; } };
struct EStoreBf { bf16* C; int ldc, pad; __device__ void operator()(int m, int n0, const float (&a)[8]) const {
    *(uint4*)(C + (size_t)m * ldc + n0) = make_uint4(pk2(a[0], a[1]), pk2(a[2], a[3]), pk2(a[4], a[5]), pk2(a[6], a[7])); } };
struct EQup { bf16* QM; const float* rq; __device__ void operator()(int m, int n0, const float (&a)[8]) const { const float r = rq[m];
    *(uint4*)(QM + (size_t)m * 768 + n0) = make_uint4(pk2(a[0] * r, a[1] * r), pk2(a[2] * r, a[3] * r), pk2(a[4] * r, a[5] * r), pk2(a[6] * r, a[7] * r)); } };
struct EKVup { bf16 *KM, *VM; const float* rkv; __device__ void operator()(int m, int n0, const float (&a)[8]) const { const float r = rkv[m];
    const int h = n0 >> 7, j = n0 & 127; bf16* dst = j < 64 ? KM + (size_t)m * 768 + h * 96 + j : VM + (size_t)m * 512 + h * 64 + (j - 64);
    *(uint4*)dst = make_uint4(pk2(a[0] * r, a[1] * r), pk2(a[2] * r, a[3] * r), pk2(a[4] * r, a[5] * r), pk2(a[6] * r, a[7] * r)); } };
struct EMerge { float* YF; bf16* YB; const bf16* P; int i, pad; __device__ void operator()(int m, int n0, const float (&a)[8]) const {
    float* y = YF + (size_t)m * D + n0; const bf16* g = P + (size_t)m * LDP + C_GATE + i * D + n0; float o[8];
#pragma unroll
    for (int j = 0; j < 8; ++j) { o[j] = sigmoidf_(bf2f(g[j])) * a[j]; if (i > 0) o[j] += y[j]; }
    if (i < 2) {
#pragma unroll
        for (int j = 0; j < 8; ++j) y[j] = o[j]; }
    else *(uint4*)(YB + (size_t)m * D + n0) = make_uint4(pk2(o[0], o[1]), pk2(o[2], o[3]), pk2(o[4], o[5]), pk2(o[6], o[7])); } };
struct EWout { Ptrs p; int l, pad; __device__ void operator()(int m, int n0, const float (&a)[8]) const {
    const float* xs = xrow_src(p, l, m) + n0; const float* g1 = (const float*)(p.ws + WS_MOD) + ((size_t)l * 17 + mod_row(m)) * 6 * D + 2 * D + n0;
    float* xb = (float*)(p.ws + WS_XB) + (size_t)m * D + n0;
#pragma unroll
    for (int j = 0; j < 8; ++j) xb[j] = xs[j] + g1[j] * a[j]; } };

__device__ __forceinline__ bool moe_tile(const unsigned* cnt, int ti, int gran, int& e, int& r0, int& ne, int& pstart) {
    int ps = 0;
    for (int x = 0; x < NEXP; ++x) { const int c = (int)cnt[x], nt = (c + gran - 1) / gran;
        if (ti < nt) { e = x; r0 = ti * gran; ne = c; pstart = ps; return true; }
        ti -= nt; ps += (c + 255) & ~255; }
    return false;
}
struct AGather { const bf16* H; const int* list; __device__ float operator()(int m, int k) const { return bf2f(H[(size_t)list[m] * D + k]); } };
struct EGu { bf16* ACT; const float* b; __device__ void operator()(int m, int n0, const float (&a)[8]) const {
    float o[4];
#pragma unroll
    for (int i = 0; i < 4; ++i) { float g = a[2 * i] + b[n0 + 2 * i], u = a[2 * i + 1] + b[n0 + 2 * i + 1]; g = fminf(g, 7.f); u = fminf(fmaxf(u, -7.f), 7.f); o[i] = (u + 1.f) * (g * sigmoidf_(1.702f * g)); }
    *(uint2*)(ACT + (size_t)m * DEXP + (n0 >> 1)) = make_uint2(pk2(o[0], o[1]), pk2(o[2], o[3])); } };
struct EDn { bf16* YM; const float* b; __device__ void operator()(int m, int n0, const float (&a)[8]) const {
    *(uint4*)(YM + (size_t)m * D + n0) = make_uint4(pk2(a[0] + b[n0], a[1] + b[n0 + 1]), pk2(a[2] + b[n0 + 2], a[3] + b[n0 + 3]), pk2(a[4] + b[n0 + 4], a[5] + b[n0 + 5]), pk2(a[6] + b[n0 + 6], a[7] + b[n0 + 7])); } };
__global__ __launch_bounds__(256) void k_moe_gu(Ptrs p, int l) {
    __shared__ float As[16][132], Ws[16][132];
    const unsigned* cnt = (const unsigned*)(p.ws + WS_CTL) + CW_CNT + 32 * l;
    int e, r0, ne, ps; if (!moe_tile(cnt, blockIdx.y, 128, e, r0, ne, ps)) return;
    AGather af{(const bf16*)(p.ws + WS_H), (const int*)(p.ws + WS_LIST) + (size_t)e * NTOK + r0};
    WF32 wf{p.w_gu + ((size_t)l * NEXP + e) * D * 2 * DEXP, 2 * DEXP};
    EGu ef{(bf16*)(p.ws + WS_ACT) + (size_t)(ps + r0) * DEXP, p.b_gu + ((size_t)l * NEXP + e) * 2 * DEXP};
    sgemm_tile(ne - r0, 2 * DEXP, D, 0, blockIdx.x * 128, af, wf, ef, As, Ws);
}
__global__ __launch_bounds__(256) void k_moe_dn(Ptrs p, int l) {
    __shared__ float As[16][132], Ws[16][132];
    const unsigned* cnt = (const unsigned*)(p.ws + WS_CTL) + CW_CNT + 32 * l;
    int e, r0, ne, ps; if (!moe_tile(cnt, blockIdx.y, 128, e, r0, ne, ps)) return;
    ABf af{(const bf16*)(p.ws + WS_ACT) + (size_t)(ps + r0) * DEXP, DEXP};
    WF32 wf{p.w_dn + ((size_t)l * NEXP + e) * DEXP * D, D};
    EDn ef{(bf16*)(p.ws + WS_YM) + (size_t)(ps + r0) * D, p.b_dn + ((size_t)l * NEXP + e) * D};
    sgemm_tile(ne - r0, D, DEXP, 0, blockIdx.x * 128, af, wf, ef, As, Ws);
}

__global__ __launch_bounds__(256) void k_prep(Ptrs p, int l) {
    const int lane = threadIdx.x & 63, row = blockIdx.x * 4 + (threadIdx.x >> 6);
    const bf16* P = (const bf16*)(p.ws + WS_P) + (size_t)row * LDP;
    const bool lat = row < NLAT; const int t = lat ? row % SEQ : (row - NLAT) % CTXL, slen = lat ? SEQ : CTXL;
    { float s = 0.f;
#pragma unroll
      for (int j = 0; j < 6; ++j) { const float v = bf2f(P[C_CQ + lane + 64 * j]); s += v * v; }
      s = wave_sum(s); if (lane == 0) ((float*)(p.ws + WS_RQ))[row] = rsqrtf(s * (1.f / 384.f) + EPS);
      s = 0.f;
#pragma unroll
      for (int j = 0; j < 4; ++j) { const float v = bf2f(P[C_CKV + lane + 64 * j]); s += v * v; }
      s = wave_sum(s); if (lane == 0) ((float*)(p.ws + WS_RKV))[row] = rsqrtf(s * (1.f / 256.f) + EPS); }
    const float prow = (float)(t / 64), pcol = (float)(t % 64);
    { bf16* QS = (bf16*)(p.ws + WS_QS) + (size_t)row * 512; bf16* KS = (bf16*)(p.ws + WS_KS) + (size_t)row * 128;
      for (int it = 0; it < 5; ++it) { const int pi = lane + 64 * it;
        const bool isq = pi < 256; const int hh = isq ? pi / 32 : (pi - 256) / 32, i = pi % 32;
        const bf16* src = P + (isq ? C_SQ : C_SK) + hh * 64; bf16* dst = (isq ? QS : KS) + hh * 64;
        const float x1 = bf2f(src[i]), x2 = bf2f(src[i + 32]);
        float cs = 1.f, sn = 0.f;
        if (lat) { const float inv = powf(10000.f, -(float)(i & 15) / 16.f); const float ang = (i < 16 ? prow : pcol) * inv; cs = cosf(ang); sn = sinf(ang); }
        dst[i] = f2bf(x1 * cs - x2 * sn); dst[i + 32] = f2bf(x2 * cs + x1 * sn); } }
    if (lane < 16) { const int i = lane; const float x1 = bf2f(P[C_KR + i]), x2 = bf2f(P[C_KR + i + 16]);
        float cs = 1.f, sn = 0.f;
        if (lat) { const float inv = powf(10000.f, -(float)(i & 7) / 8.f); const float ang = (i < 8 ? prow : pcol) * inv; cs = cosf(ang); sn = sinf(ang); }
        const bf16 o1 = f2bf(x1 * cs - x2 * sn), o2 = f2bf(x2 * cs + x1 * sn);
        bf16* KM = (bf16*)(p.ws + WS_KM) + (size_t)row * 768;
#pragma unroll
        for (int h = 0; h < 8; ++h) { KM[h * 96 + 64 + i] = o1; KM[h * 96 + 80 + i] = o2; } }
    { const float* cw = p.conv_w + (size_t)l * 5 * 1536;
      bf16* DQ = (bf16*)(p.ws + WS_DQ) + (size_t)row * 512; bf16* DK = (bf16*)(p.ws + WS_DK) + (size_t)row * 512; bf16* DV = (bf16*)(p.ws + WS_DV) + (size_t)row * 512;
      for (int j = 0; j < 24; ++j) { const int c = lane + 64 * j; float y = 0.f;
#pragma unroll
        for (int tap = 0; tap < 5; ++tap) { const int tt = t + tap - 2; if (tt >= 0 && tt < slen) y += bf2f(P[(ptrdiff_t)(tap - 2) * LDP + C_DQKV + c]) * cw[tap * 1536 + c]; }
        y = siluf_(y);
        if (j < 16) { const float ss = wave_sum(y * y); y *= rsqrtf(ss + EPS); if (j < 8) y *= 0.125f; }
        if (j < 8) DQ[c] = f2bf(y); else if (j < 16) DK[c - 512] = f2bf(y); else DV[c - 1024] = f2bf(y); } }
    if (lane < 16) { const float braw = bf2f(P[C_DBETA + lane]), araw = bf2f(P[C_DA + lane]);
        ((float*)(p.ws + WS_DB))[(size_t)row * 16 + lane] = sigmoidf_(braw);
        ((float*)(p.ws + WS_DG))[(size_t)row * 16 + lane] = -__expf(p.a_log[l * 16 + lane]) * softplusf_(araw + p.dt_bias[l * 16 + lane]); }
}
__global__ void k_rope_q(Ptrs p) {
    const int idx = blockIdx.x * 256 + threadIdx.x; const int i = idx & 15, h = (idx >> 4) & 7, row = idx >> 7;
    if (row >= NLAT) return;
    const int t = row % SEQ; bf16* q = (bf16*)(p.ws + WS_QM) + (size_t)row * 768 + h * 96 + 64;
    const float inv = powf(10000.f, -(float)(i & 7) / 8.f); const float ang = (i < 8 ? (float)(t / 64) : (float)(t % 64)) * inv; const float cs = cosf(ang), sn = sinf(ang);
    const float x1 = bf2f(q[i]), x2 = bf2f(q[i + 16]);
    q[i] = f2bf(x1 * cs - x2 * sn); q[i + 16] = f2bf(x2 * cs + x1 * sn);
}

template <int DK, int MODE>
__global__ __launch_bounds__(64) void k_attn(Ptrs p, int l, int ctxq) {
    constexpr int DV = 64, KT = 32;
    __shared__ float Ks[KT][DK], Vs[KT][DV];
    const int qb = blockIdx.x, h = blockIdx.y, b = blockIdx.z, tid = threadIdx.x;
    const int t = qb * 64 + tid, qrow = ctxq ? NLAT + b * CTXL + t : b * SEQ + t;
    const bf16* Qp = MODE == 0 ? (const bf16*)(p.ws + WS_QM) + (size_t)qrow * 768 + h * 96 : (const bf16*)(p.ws + WS_QS) + (size_t)qrow * 512 + h * 64;
    const float scale = MODE == 0 ? 0.10206207261596575f : 0.125f;
    float q[DK], o[DV];
#pragma unroll
    for (int i = 0; i < DK; ++i) q[i] = bf2f(Qp[i]) * scale;
#pragma unroll
    for (int i = 0; i < DV; ++i) o[i] = 0.f;
    float m = -1e30f, lsum = 0.f;
    if (MODE == 1) { m = p.sink[l * 8 + h]; lsum = 1.f; }
    if (MODE == 0 && !ctxq) {
#pragma unroll
        for (int i = 0; i < 16; ++i) { const float inv = powf(10000.f, -(float)(i & 7) / 8.f); const float ang = (i < 8 ? (float)(t / 64) : (float)(t % 64)) * inv; const float cs = cosf(ang), sn = sinf(ang);
            const float x1 = q[DK - 32 + i], x2 = q[DK - 16 + i]; q[DK - 32 + i] = x1 * cs - x2 * sn; q[DK - 16 + i] = x2 * cs + x1 * sn; } }
    for (int seg = 0; seg < (ctxq ? 1 : 2); ++seg) {
        int k0 = 0, k1 = CTXL; if (seg == 1) { k0 = 0; k1 = SEQ; if (MODE == 1) { k0 = max(0, qb * 64 - 128); k1 = min(SEQ, qb * 64 + 64 + 128); } }
        const int rbase = seg == 0 ? NLAT + b * CTXL : b * SEQ;
        for (int kt = k0; kt < k1; kt += KT) {
            __syncthreads();
            for (int e = tid; e < KT * DK; e += 64) { const int kk = e / DK, d = e % DK; const int row = rbase + kt + kk;
                Ks[kk][d] = MODE == 0 ? bf2f(((const bf16*)(p.ws + WS_KM))[(size_t)row * 768 + h * 96 + d]) : bf2f(((const bf16*)(p.ws + WS_KS))[(size_t)row * 128 + (h >> 2) * 64 + d]); }
            for (int e = tid; e < KT * DV; e += 64) { const int kk = e / DV, d = e % DV; const int row = rbase + kt + kk;
                Vs[kk][d] = MODE == 0 ? bf2f(((const bf16*)(p.ws + WS_VM))[(size_t)row * 512 + h * 64 + d]) : bf2f(((const bf16*)(p.ws + WS_P))[(size_t)row * LDP + C_SV + (h >> 2) * 64 + d]); }
            __syncthreads();
            for (int kk = 0; kk < KT; ++kk) {
                if (MODE == 1 && seg == 1) { const int dlt = kt + kk - t; if (dlt > 128 || dlt < -128) continue; }
                float s = 0.f;
#pragma unroll
                for (int i = 0; i < DK; ++i) s = fmaf(q[i], Ks[kk][i], s);
                const float mn = fmaxf(m, s), c = __expf(m - mn), pe = __expf(s - mn);
                lsum = lsum * c + pe; m = mn;
#pragma unroll
                for (int i = 0; i < DV; ++i) o[i] = fmaf(pe, Vs[kk][i], o[i] * c);
            }
        }
    }
    const float inv = 1.f / lsum;
    bf16* O = (bf16*)(p.ws + WS_BR) + (size_t)(MODE == 0 ? 0 : 1) * NTOK * 512 + (size_t)qrow * 512 + h * 64;
#pragma unroll
    for (int i = 0; i < DV; i += 2) *(unsigned*)(O + i) = pk2(o[i] * inv, o[i + 1] * inv);
}

__global__ __launch_bounds__(64) void k_dn_scan(Ptrs p) {
    constexpr int CH = 32;
    __shared__ float qs[CH][64], ks[CH][64], vs[CH][64], gs[CH], bs[CH]; __shared__ int rs[CH];
    const int b = blockIdx.x, h = blockIdx.y, dir = blockIdx.z, v = threadIdx.x;
    float S[64];
#pragma unroll
    for (int i = 0; i < 64; ++i) S[i] = 0.f;
    float* DO = (float*)(p.ws + WS_DO) + (size_t)dir * NTOK * 512;
    for (int s0 = 0; s0 < CTXL + SEQ; s0 += CH) {
        __syncthreads();
        for (int e = v; e < CH * 64; e += 64) { const int i = e >> 6, d = e & 63; const int s = s0 + i;
            const int row = s < CTXL ? NLAT + b * CTXL + (dir ? CTXL - 1 - s : s) : b * SEQ + (dir ? SEQ - 1 - (s - CTXL) : (s - CTXL));
            qs[i][d] = bf2f(((const bf16*)(p.ws + WS_DQ))[(size_t)row * 512 + h * 64 + d]); ks[i][d] = bf2f(((const bf16*)(p.ws + WS_DK))[(size_t)row * 512 + h * 64 + d]);
            vs[i][d] = bf2f(((const bf16*)(p.ws + WS_DV))[(size_t)row * 512 + h * 64 + d]);
            if (d == 0) { rs[i] = row; gs[i] = ((const float*)(p.ws + WS_DG))[(size_t)row * 16 + dir * 8 + h]; bs[i] = ((const float*)(p.ws + WS_DB))[(size_t)row * 16 + dir * 8 + h]; } }
        __syncthreads();
        for (int i = 0; i < CH; ++i) {
            float kS = 0.f;
#pragma unroll
            for (int k = 0; k < 64; ++k) kS = fmaf(ks[i][k], S[k], kS);
            const float a = __expf(gs[i]), dl = bs[i] * (vs[i][v] - a * kS);
            float o = 0.f;
#pragma unroll
            for (int k = 0; k < 64; ++k) { S[k] = fmaf(ks[i][k], dl, a * S[k]); o = fmaf(qs[i][k], S[k], o); }
            DO[(size_t)rs[i] * 512 + h * 64 + v] = o;
        }
    }
}
__global__ __launch_bounds__(256) void k_dn_post(Ptrs p, int l, int nrows) {
    const int lane = threadIdx.x & 63, row = blockIdx.x * 4 + (threadIdx.x >> 6);
    if (row >= nrows) return;
    const float* o0 = (const float*)(p.ws + WS_DO) + (size_t)row * 512 + lane * 8; const float* o1 = o0 + (size_t)NTOK * 512;
    float v[8], s = 0.f;
#pragma unroll
    for (int i = 0; i < 8; ++i) { v[i] = o0[i] + o1[i]; s += v[i] * v[i]; }
    s += __shfl_xor(s, 1); s += __shfl_xor(s, 2); s += __shfl_xor(s, 4);
    const float r = rsqrtf(s * (1.f / 64.f) + EPS);
    const bf16* z = (const bf16*)(p.ws + WS_P) + (size_t)row * LDP + C_DZ + lane * 8; const float* ng = p.dn_norm_g + l * 64 + (lane & 7) * 8;
    float o[8];
#pragma unroll
    for (int i = 0; i < 8; ++i) o[i] = v[i] * r * ng[i] * siluf_(bf2f(z[i]));
    *(uint4*)((bf16*)(p.ws + WS_BR) + (size_t)2 * NTOK * 512 + (size_t)row * 512 + lane * 8) = make_uint4(pk2(o[0], o[1]), pk2(o[2], o[3]), pk2(o[4], o[5]), pk2(o[6], o[7]));
}

constexpr int R2_ROWS = 64;
__global__ __launch_bounds__(256) void k_norm2_router(Ptrs p, int l, int nrows) {
    __shared__ float hrow[4][D]; __shared__ unsigned hist[NEXP], base[NEXP]; __shared__ int se[R2_ROWS * 4], sp[R2_ROWS * 4];
    const int lane = threadIdx.x & 63, w = threadIdx.x >> 6;
    if (threadIdx.x < NEXP) hist[threadIdx.x] = 0u;
    __syncthreads();
    const float* rw = p.router_w + (size_t)l * D * NEXP; const float* rb = p.router_b + l * NEXP;
    unsigned* cnt = (unsigned*)(p.ws + WS_CTL) + CW_CNT + 32 * l;
    int* TE = (int*)(p.ws + WS_TOPE); int* TP = (int*)(p.ws + WS_TOPP); float* TG = (float*)(p.ws + WS_TOPG);
    for (int rr = w; rr < R2_ROWS; rr += 4) { const int row = blockIdx.x * R2_ROWS + rr; if (row >= nrows) break;
        const float* src = (const float*)(p.ws + WS_XB) + (size_t)row * D;
        float v[16]; float s = 0.f;
#pragma unroll
        for (int j = 0; j < 4; ++j) { const float4 t4 = *(const float4*)(src + j * 256 + lane * 4); v[4 * j] = t4.x; v[4 * j + 1] = t4.y; v[4 * j + 2] = t4.z; v[4 * j + 3] = t4.w; }
#pragma unroll
        for (int i = 0; i < 16; ++i) s += v[i] * v[i];
        const float r = rsqrtf(wave_sum(s) * (1.f / D) + EPS);
        const float* ng = p.norm2_g + (size_t)l * D; const float* modv = (const float*)(p.ws + WS_MOD) + ((size_t)l * 17 + mod_row(row)) * 6 * D + 3 * D;
        bf16* h = (bf16*)(p.ws + WS_H) + (size_t)row * D;
#pragma unroll
        for (int j = 0; j < 4; ++j) { float o[4];
#pragma unroll
            for (int i = 0; i < 4; ++i) { const int c = j * 256 + lane * 4 + i; o[i] = v[4 * j + i] * r * ng[c] * (1.f + modv[D + c]) + modv[c]; hrow[w][c] = o[i]; }
            *(uint2*)(h + j * 256 + lane * 4) = make_uint2(pk2(o[0], o[1]), pk2(o[2], o[3])); }
        asm volatile("s_waitcnt lgkmcnt(0)" ::: "memory");
        const int e = lane & 31, kh = lane >> 5; float acc = 0.f;
        for (int k = kh * 512; k < kh * 512 + 512; ++k) acc = fmaf(hrow[w][k], rw[(size_t)k * NEXP + e], acc);
        acc += __shfl_xor(acc, 32); acc += rb[e];
        float cur = acc, myv = 0.f, mx = 0.f, den = 0.f; int mye = 0;
#pragma unroll
        for (int k = 0; k < 4; ++k) { float bv = cur; int be = e;
#pragma unroll
            for (int o = 1; o < 32; o <<= 1) { const float ov = __shfl_xor(bv, o); const int oe = __shfl_xor(be, o); if (ov > bv || (ov == bv && oe < be)) { bv = ov; be = oe; } }
            if (k == 0) mx = bv;
            const float ex = __expf(bv - mx); den += ex;
            if (lane == k) { myv = ex; mye = be; }
            if (e == be) cur = -3.0e38f; }
        if (lane < 4) { const int k = lane;
            TE[(size_t)row * 4 + k] = mye; TG[(size_t)row * 4 + k] = myv / den; se[rr * 4 + k] = mye; sp[rr * 4 + k] = (int)atomicAdd(&hist[mye], 1u); }
    }
    __syncthreads();
    if (threadIdx.x < NEXP) base[threadIdx.x] = atomicAdd(&cnt[threadIdx.x], hist[threadIdx.x]);
    __syncthreads();
    int* LIST = (int*)(p.ws + WS_LIST);
    for (int i = threadIdx.x; i < R2_ROWS * 4; i += 256) { const int row = blockIdx.x * R2_ROWS + (i >> 2); if (row >= nrows) break;
        const int e = se[i]; const int pos = sp[i] + (int)base[e];
        TP[(size_t)row * 4 + (i & 3)] = pos; LIST[(size_t)e * NTOK + pos] = row; }
}

template <class AF, class WF, class EF>
static void run_sgemm(hipStream_t st, int M, int N, int K, const AF& af, const WF& wf, const EF& ef) {
    hipLaunchKernelGGL((k_sgemm<AF, WF, EF>), dim3((N + 127) / 128, (M + 127) / 128), dim3(256), 0, st, M, N, K, af, wf, ef);
}
static Ptrs make_ptrs(void* const* d_in, void* d_out, void* d_ws) {
    Ptrs p{};
    const float** f = (const float**)&p;
    for (int i = 0; i < 27; ++i) f[i] = (const float*)d_in[i];
    p.out = (float*)d_out; p.ws = (unsigned char*)d_ws;
    return p;
}
static void simple_layer_front(const Ptrs& p, hipStream_t st, int l) {
    unsigned char* ws = p.ws;
    hipLaunchKernelGGL(k_norm1, dim3(NTOK / 4), dim3(256), 0, st, p, l, NTOK, 0);
    run_sgemm(st, NTOK, DIN, D, ABf{(const bf16*)(ws + WS_H), D, 0}, WF32{p.w_in + (size_t)l * D * DIN, DIN, 0}, EStoreBf{(bf16*)(ws + WS_P), LDP, 0});
    hipLaunchKernelGGL(k_prep, dim3(NTOK / 4), dim3(256), 0, st, p, l);
    run_sgemm(st, NTOK, 768, 384, ABfG{(const bf16*)(ws + WS_P) + C_CQ, p.q_norm_g + l * 384, LDP, 0}, WF32{p.w_q_up + (size_t)l * 384 * 768, 768, 0}, EQup{(bf16*)(ws + WS_QM), (const float*)(ws + WS_RQ)});
    run_sgemm(st, NTOK, 1024, 256, ABfG{(const bf16*)(ws + WS_P) + C_CKV, p.kv_norm_g + l * 256, LDP, 0}, WF32{p.w_kv_up + (size_t)l * 256 * 1024, 1024, 0},
              EKVup{(bf16*)(ws + WS_KM), (bf16*)(ws + WS_VM), (const float*)(ws + WS_RKV)});
}
static void simple_mixers(const Ptrs& p, hipStream_t st, int l) {
    hipLaunchKernelGGL((k_attn<96, 0>), dim3(SEQ / 64, 8, NB), dim3(64), 0, st, p, l, 0);
    if (l == 0) hipLaunchKernelGGL((k_attn<96, 0>), dim3(CTXL / 64, 8, NB), dim3(64), 0, st, p, l, 1);
    hipLaunchKernelGGL((k_attn<64, 1>), dim3(SEQ / 64, 8, NB), dim3(64), 0, st, p, l, 0);
    if (l == 0) hipLaunchKernelGGL((k_attn<64, 1>), dim3(CTXL / 64, 8, NB), dim3(64), 0, st, p, l, 1);
    hipLaunchKernelGGL(k_dn_scan, dim3(NB, 8, 2), dim3(64), 0, st, p);
    hipLaunchKernelGGL(k_dn_post, dim3((l == 0 ? NTOK : NLAT) / 4), dim3(256), 0, st, p, l, l == 0 ? NTOK : NLAT);
}
static void simple_merge(const Ptrs& p, hipStream_t st, int l) {
    unsigned char* ws = p.ws; const int nq = l == 0 ? NTOK : NLAT;
    for (int i = 0; i < 3; ++i)
        run_sgemm(st, nq, D, 512, ABf{(const bf16*)(ws + WS_BR) + (size_t)i * NTOK * 512, 512, 0}, WF32{p.w_branch + ((size_t)l * 3 + i) * 512 * D, D, 0},
                  EMerge{(float*)(ws + WS_YF), (bf16*)(ws + WS_YB), (const bf16*)(ws + WS_P), i, 0});
    run_sgemm(st, nq, D, D, ABf{(const bf16*)(ws + WS_YB), D, 0}, WF32{p.w_out + (size_t)l * D * D, D, 0}, EWout{p, l, 0});
}
static void simple_moe(const Ptrs& p, hipStream_t st, int l) {
    const int nq = l == 0 ? NTOK : NLAT;
    hipLaunchKernelGGL(k_norm2_router, dim3(nq / R2_ROWS), dim3(256), 0, st, p, l, nq);
    hipLaunchKernelGGL(k_moe_gu, dim3(2 * DEXP / 128, NTOK * 4 / 128 + NEXP), dim3(256), 0, st, p, l);
    hipLaunchKernelGGL(k_moe_dn, dim3(D / 128, NTOK * 4 / 128 + NEXP), dim3(256), 0, st, p, l);
}

#define LAS __attribute__((address_space(3)))
#define GAS __attribute__((address_space(1)))
typedef short bf16x8 __attribute__((ext_vector_type(8)));
typedef float f32x4 __attribute__((ext_vector_type(4)));
typedef float f32x2 __attribute__((ext_vector_type(2)));
typedef unsigned u32x4 __attribute__((ext_vector_type(4)));
typedef unsigned u32x2 __attribute__((ext_vector_type(2)));
__device__ __forceinline__ int lane_id() { int l; asm volatile("v_mbcnt_lo_u32_b32 %0, -1, 0\n\tv_mbcnt_hi_u32_b32 %0, -1, %0" : "=v"(l)); return l; }
constexpr int NWAVES = 8, NTHR = 512;
constexpr int BM = 256, BK = 64, HALF = 128, HTB = HALF * BK * 2, STAGE_BYTES = 8 * HTB;
constexpr int LDS_MISC_OFF = STAGE_BYTES;
constexpr int LDS_TAB_OFF = STAGE_BYTES + 1024;
constexpr int LDS_BYTES = 147456;
constexpr size_t WS_ROPES = 5 * MiB + 256 * 1024, WS_ROPEM = 8 * MiB + 512 * 1024;
constexpr size_t WS_Z = WS_PREP;
constexpr size_t WS_WOUT3 = WS_END;
constexpr size_t WS_END2 = WS_END + 12 * MiB;

#define XB_TMO      128
#define XB_XCNT(j)  (256  + 64 * (j))
#define XB_XSUB(j)  (1280 + 64 * (j))
#define XB_XGEN(j)  (2304 + 64 * (j))
#define XB_TOP      3328
#define XB_TOPGEN   3392
#define XCD_BAR_WORDS 3456
#define XB_SPIN_CAP (1u << 18)
__device__ __forceinline__ unsigned xb_ld(unsigned* p)              { return __hip_atomic_load(p, __ATOMIC_RELAXED, __HIP_MEMORY_SCOPE_AGENT); }
__device__ __forceinline__ unsigned xb_add(unsigned* p, unsigned v) { return __hip_atomic_fetch_add(p, v, __ATOMIC_RELAXED, __HIP_MEMORY_SCOPE_AGENT); }
__device__ __forceinline__ unsigned xb_xcc_id() { return (unsigned)__builtin_amdgcn_s_getreg((3 << 11) | 20) & 0xFu; }
#define XB_SPIN(cond, bar) do { unsigned _sp = 0; while (cond) { __builtin_amdgcn_s_sleep(1); \
    if ((++_sp & 255u) == 0u) { if (xb_ld(&(bar)[XB_TMO])) break; if (_sp > XB_SPIN_CAP) { atomicAdd(&(bar)[XB_TMO], 1u); break; } } } } while (0)
struct XcdBarrier { unsigned* bar; unsigned x; volatile LAS unsigned* st; };
__device__ __forceinline__ XcdBarrier xcd_barrier_post(unsigned* bar, volatile LAS unsigned* st) {
    XcdBarrier b; b.bar = bar; b.x = xb_xcc_id(); b.st = st;
    if (threadIdx.x == 0) (void)xb_add(&bar[XB_XCNT(b.x)], 1u);
    return b;
}
__device__ __forceinline__ void xcd_barrier_complete(unsigned* bar, unsigned x, unsigned& nloc, unsigned& nx) {
    const unsigned G = gridDim.x * gridDim.y * gridDim.z;
    unsigned sum, cnt, mine, sp = 0u;
    for (;;) {
        sum = 0u; cnt = 0u; mine = 0u;
#pragma unroll
        for (unsigned j = 0; j < 16; ++j) { const unsigned c = xb_ld(&bar[XB_XCNT(j)]); sum += c; cnt += (c > 0u) ? 1u : 0u; mine = (j == x) ? c : mine; }
        if (sum == G) break;
        __builtin_amdgcn_s_sleep(1);
        if ((++sp & 255u) == 0u) { if (xb_ld(&bar[XB_TMO])) break; if (sp > XB_SPIN_CAP) { atomicAdd(&bar[XB_TMO], 1u); break; } }
    }
    nloc = mine > 0u ? mine : 1u; nx = cnt > 0u ? cnt : 1u;
}
__device__ __noinline__ void xcd_barrier_impl(unsigned* bar, unsigned bx, unsigned st_off, int wave) {
    volatile LAS unsigned* st = (volatile LAS unsigned*)(unsigned long long)st_off;
    asm volatile("s_waitcnt vmcnt(0)" ::: "memory");
    __syncthreads();
    if (wave == 0 && lane_id() == 0) {
        __builtin_amdgcn_s_waitcnt(0);
        unsigned nloc = st[0], nx = st[1];
        if (nloc == 0u) { xcd_barrier_complete(bar, bx, nloc, nx); st[0] = nloc; st[1] = nx; }
        const unsigned old = xb_add(&bar[XB_XSUB(bx)], 1u);
        const unsigned gen = old / nloc;
        if (old + 1u == (gen + 1u) * nloc) {
            __builtin_amdgcn_fence(__ATOMIC_RELEASE, "agent");
            asm volatile("s_waitcnt vmcnt(0)" ::: "memory");
            const unsigned og = xb_add(&bar[XB_TOP], 1u);
            const unsigned tg = og / nx;
            if (og + 1u == (tg + 1u) * nx) xb_add(&bar[XB_TOPGEN], 1u);
            else XB_SPIN(xb_ld(&bar[XB_TOPGEN]) == tg, bar);
            __builtin_amdgcn_fence(__ATOMIC_ACQUIRE, "agent");
            xb_add(&bar[XB_XGEN(bx)], 1u);
            asm volatile("s_waitcnt vmcnt(0)" ::: "memory");
        } else {
            XB_SPIN(xb_ld(&bar[XB_XGEN(bx)]) == gen, bar);
            __builtin_amdgcn_fence(__ATOMIC_ACQUIRE, "agent");
            asm volatile("s_waitcnt vmcnt(0)" ::: "memory");
        }
    }
    __syncthreads();
}
__device__ __forceinline__ void xcd_barrier(const XcdBarrier& b, int wave) { xcd_barrier_impl(b.bar, b.x, (unsigned)(unsigned long long)b.st, wave); }

#ifndef DENSE_WGM
#define DENSE_WGM 8
#endif
#ifndef GEMM_SP2
#define GEMM_SP2 1
#endif
#ifndef GEMM_ALIGN
#define GEMM_ALIGN 1
#endif
__device__ __forceinline__ int lds_byte(int r, int c) { const int st = (r >> 4) * 2 + (c >> 5), rr = r & 15, cc = c & 31, ob = rr * 64 + cc * 2; return st * 1024 + (ob ^ (((ob >> 9) & 1) << 5)); }
__device__ __forceinline__ void stage_rc(int b, int& R, int& C) { const int st = b / 1024, sb = b % 1024, swz = sb ^ (((sb >> 9) & 1) << 5); R = (st >> 1) * 16 + swz / 64; C = (st & 1) * 32 + (swz % 64) / 2; }
__device__ __forceinline__ int perm32(int rho) { const int n = rho >> 4, i = rho & 15; return 8 * (i >> 2) + 4 * n + (i & 3); }
typedef __bf16 bf16x2v __attribute__((ext_vector_type(2)));
__device__ __forceinline__ unsigned cvt_pk_bf16(float lo, float hi) { return __builtin_bit_cast(unsigned, __builtin_convertvector((f32x2){lo, hi}, bf16x2v)); }

struct GUnit { const char* A0; const char* A1; const char* B; const int* rows; int nvalid, rowbase, colbase, e, pm; };

template <class Epi, class Sched, bool GATHER>
__device__ __forceinline__ void gemm_phase(LAS unsigned char* lds, const int K, const int lda  , const Sched& S, const Epi& E, const int wid) {
    const int lane = lane_id(), tid = wid * 64 + lane;
    const int wr = wid >> 2, wc = wid & 3, fr = lane & 15, fq = lane >> 4;
    const int nt = K / BK;
    unsigned voffB[2], vA[2][2], vAn[2][2];
#pragma unroll
    for (int i = 0; i < 2; ++i) { int sR, sC; stage_rc(tid * 16 + i * 8192, sR, sC); const int Rb = Epi::PERM ? ((sR & ~31) + perm32(sR & 31)) : sR; voffB[i] = (unsigned)(Rb * K + sC) * 2u; }
    const size_t kstep = (size_t)(BK * 2), hstepB = (size_t)HALF * K * 2;
    const unsigned ldsw = (unsigned)wid * 1024u;
    const int aoff = lds_byte(wr * 64 + fr, fq * 8), boff = lds_byte(wc * 32 + fr, fq * 8);
#define G_SA(b, h) (((b) * 2 + (h)) * HTB)
#define G_SB(b, h) ((4 + (b) * 2 + (h)) * HTB)
#define G_OPQ(x) ({ unsigned _o = (x); asm volatile("" : "+v"(_o)); _o; })
#define G_STAGE_B(bufoff, gbase) do { _Pragma("unroll") for (int _i = 0; _i < 2; ++_i) \
        __builtin_amdgcn_global_load_lds((const unsigned*)((const char*)(gbase) + G_OPQ(voffB[_i])), (LAS unsigned*)(lds + (bufoff) + ldsw + _i * 8192), 16, 0, 0); } while (0)
#define G_STAGE_A(bufoff, gbase, o0, o1) do { \
        __builtin_amdgcn_global_load_lds((const unsigned*)((const char*)(gbase) + G_OPQ(o0)), (LAS unsigned*)(lds + (bufoff) + ldsw), 16, 0, 0); \
        __builtin_amdgcn_global_load_lds((const unsigned*)((const char*)(gbase) + G_OPQ(o1)), (LAS unsigned*)(lds + (bufoff) + ldsw + 8192), 16, 0, 0); } while (0)
#define G_LDA(dst, b, h) do { _Pragma("unroll") for (int m = 0; m < 4; ++m) _Pragma("unroll") for (int k = 0; k < 2; ++k) dst[m][k] = *(const LAS bf16x8*)(lds + G_SA(b, h) + aoff + m * 2048 + k * 1024); } while (0)
#define G_LDB(dst, b, h) do { _Pragma("unroll") for (int n = 0; n < 2; ++n) _Pragma("unroll") for (int k = 0; k < 2; ++k) dst[n][k] = *(const LAS bf16x8*)(lds + G_SB(b, h) + boff + n * 2048 + k * 1024); } while (0)
#define G_MMA(ai, bj, At, Bt) do { __builtin_amdgcn_s_setprio(1); _Pragma("unroll") for (int m = 0; m < 4; ++m) _Pragma("unroll") for (int n = 0; n < 2; ++n) _Pragma("unroll") for (int k = 0; k < 2; ++k) \
        acc[ai][bj][m][n] = __builtin_amdgcn_mfma_f32_16x16x32_bf16(Bt[n][k], At[m][k], acc[ai][bj][m][n], 0, 0, 0); __builtin_amdgcn_s_setprio(0); } while (0)
#define G_WAIT_V(n) asm volatile("s_waitcnt vmcnt(" #n ")" ::: "memory")
#define G_WAIT_L(n) asm volatile("s_waitcnt lgkmcnt(" #n ")" ::: "memory")
#define G_BAR __builtin_amdgcn_s_barrier()
#define G_SCHED __builtin_amdgcn_sched_barrier(0)
#define G_VOFF(u, vv) do { int _ld[2][2]; if (GATHER) { _Pragma("unroll") for (int _h = 0; _h < 2; ++_h) _Pragma("unroll") for (int _i = 0; _i < 2; ++_i) { int _R, _C; stage_rc(tid * 16 + _i * 8192, _R, _C); _ld[_h][_i] = (u).rows[_R + 128 * _h]; } } \
        _Pragma("unroll") for (int _h = 0; _h < 2; ++_h) _Pragma("unroll") for (int _i = 0; _i < 2; ++_i) { int _R, _C; stage_rc(tid * 16 + _i * 8192, _R, _C); \
        const int _ri = GATHER ? ((_R + 128 * _h) < (u).nvalid ? _ld[_h][_i] : 0) : _R; vv[_h][_i] = (unsigned)_ri * (unsigned)lda + (unsigned)_C * 2u; } } while (0)
    GUnit cur, nxt; int ui = 0;
    if (!S.next(0, cur)) return;
    G_VOFF(cur, vA);
    f32x4 acc[2][2][4][2];
#pragma unroll
    for (int a = 0; a < 2; ++a)
#pragma unroll
        for (int b = 0; b < 2; ++b)
#pragma unroll
            for (int m = 0; m < 4; ++m)
#pragma unroll
                for (int n = 0; n < 2; ++n) acc[a][b][m][n] = (f32x4){0.f, 0.f, 0.f, 0.f};
    bf16x8 At[4][2], B0[2][2], B1[2][2];
    const char* cA0 = cur.A0; const char* cA1 = cur.A1; const char* cB = cur.B;
    typename Epi::Pre pre; E.prefetch(cur, wc, fq, pre);
    if (GEMM_SP2) {
        G_STAGE_B(G_SB(0, 0), cB); G_STAGE_B(G_SB(0, 1), cB + hstepB); G_STAGE_A(G_SA(0, 0), cA0, vA[0][0], vA[0][1]); G_STAGE_A(G_SA(0, 1), cA1, vA[1][0], vA[1][1]);
        if (wr == 1) G_BAR;
        G_WAIT_V(2); G_BAR;
    } else {
        G_STAGE_B(G_SB(0, 0), cB); G_STAGE_A(G_SA(0, 0), cA0, vA[0][0], vA[0][1]); G_STAGE_B(G_SB(0, 1), cB + hstepB); G_STAGE_A(G_SA(0, 1), cA1, vA[1][0], vA[1][1]);
        if (wr == 1) G_BAR;
        G_WAIT_V(4); G_BAR;
    }
    G_STAGE_B(G_SB(1, 0), cB + kstep); G_STAGE_A(G_SA(1, 0), cA0 + kstep, vA[0][0], vA[0][1]); G_STAGE_B(G_SB(1, 1), cB + hstepB + kstep);
    G_WAIT_V(6); G_BAR;
    for (;;) {
        const bool has_next = S.next(ui + 1, nxt);
        if (has_next) { G_VOFF(nxt, vAn); }
        else {
#pragma unroll
            for (int h = 0; h < 2; ++h)
#pragma unroll
                for (int i = 0; i < 2; ++i) vAn[h][i] = vA[h][i]; }
        const char* nA0 = has_next ? nxt.A0 : cA0; const char* nA1 = has_next ? nxt.A1 : cA1; const char* nB = has_next ? nxt.B : cB;
#pragma unroll 1
        for (int t = 0; t < nt; t += 2) {
            const bool last = (t == nt - 2);
            const char* a1 = cA1 + (size_t)(t + 1) * kstep;
            const char* a20 = last ? nA0 : cA0 + (size_t)(t + 2) * kstep; const char* a21 = last ? nA1 : cA1 + (size_t)(t + 2) * kstep; const char* b2 = last ? nB : cB + (size_t)(t + 2) * kstep;
            const char* a30 = a20 + kstep; const char* b3 = b2 + kstep;
            const unsigned o00 = last ? vAn[0][0] : vA[0][0], o01 = last ? vAn[0][1] : vA[0][1], o10 = last ? vAn[1][0] : vA[1][0], o11 = last ? vAn[1][1] : vA[1][1];
            if (GEMM_SP2) {
            G_LDB(B0, 0, 0); G_LDB(B1, 0, 1); G_SCHED; G_LDA(At, 0, 0); G_STAGE_A(G_SA(1, 1), a1, vA[1][0], vA[1][1]);
            G_WAIT_V(8); G_WAIT_L(0); G_BAR; G_MMA(0, 0, At, B0); G_MMA(0, 1, At, B1); G_BAR; G_SCHED;
            G_LDA(At, 0, 1); G_STAGE_B(G_SB(0, 0), b2); G_STAGE_B(G_SB(0, 1), b2 + hstepB); G_STAGE_A(G_SA(0, 0), a20, o00, o01);
            G_WAIT_V(8); G_WAIT_L(0); G_BAR; G_MMA(1, 0, At, B0); G_MMA(1, 1, At, B1); G_BAR; G_SCHED;
            G_LDB(B0, 1, 0); G_LDB(B1, 1, 1); G_SCHED; G_LDA(At, 1, 0); G_STAGE_A(G_SA(0, 1), a21, o10, o11);
            G_WAIT_V(8); G_WAIT_L(0); G_BAR; G_MMA(0, 0, At, B0); G_MMA(0, 1, At, B1); G_BAR; G_SCHED;
            G_LDA(At, 1, 1); G_STAGE_B(G_SB(1, 0), b3); G_STAGE_B(G_SB(1, 1), b3 + hstepB); G_STAGE_A(G_SA(1, 0), a30, o00, o01);
            G_WAIT_V(8); G_WAIT_L(0); G_BAR; G_MMA(1, 0, At, B0); G_MMA(1, 1, At, B1); G_BAR; G_SCHED;
            } else {
            G_LDB(B0, 0, 0); G_SCHED; G_LDA(At, 0, 0); G_STAGE_A(G_SA(1, 1), a1, vA[1][0], vA[1][1]);
            G_WAIT_L(8); G_BAR; G_WAIT_L(0); G_MMA(0, 0, At, B0); G_BAR; G_SCHED;
            G_LDB(B1, 0, 1); G_STAGE_B(G_SB(0, 0), b2);
            G_BAR; G_WAIT_L(0); G_MMA(0, 1, At, B1); G_BAR;
            G_LDA(At, 0, 1); G_STAGE_A(G_SA(0, 0), a20, o00, o01);
            G_BAR; G_WAIT_L(0); G_MMA(1, 0, At, B0); G_BAR; G_SCHED;
            G_STAGE_B(G_SB(0, 1), b2 + hstepB);
            G_WAIT_V(6); G_BAR; G_MMA(1, 1, At, B1); G_BAR;
            G_LDB(B0, 1, 0); G_SCHED; G_LDA(At, 1, 0); G_STAGE_A(G_SA(0, 1), a21, o10, o11);
            G_WAIT_L(8); G_BAR; G_WAIT_L(0); G_MMA(0, 0, At, B0); G_BAR; G_SCHED;
            G_LDB(B1, 1, 1); G_STAGE_B(G_SB(1, 0), b3);
            G_BAR; G_WAIT_L(0); G_MMA(0, 1, At, B1); G_BAR;
            G_LDA(At, 1, 1); G_STAGE_A(G_SA(1, 0), a30, o00, o01);
            G_BAR; G_WAIT_L(0); G_MMA(1, 0, At, B0); G_BAR; G_SCHED;
            G_STAGE_B(G_SB(1, 1), b3 + hstepB);
            G_WAIT_V(6); G_BAR; G_MMA(1, 1, At, B1); G_BAR;
            }
        }
        if (GEMM_ALIGN) { if (wr == 0) G_BAR; }
        E(acc, cur, wr, wc, fr, fq, pre);
        if (!has_next) break;
#pragma unroll
        for (int a = 0; a < 2; ++a)
#pragma unroll
            for (int b = 0; b < 2; ++b)
#pragma unroll
                for (int m = 0; m < 4; ++m)
#pragma unroll
                    for (int n = 0; n < 2; ++n) acc[a][b][m][n] = (f32x4){0.f, 0.f, 0.f, 0.f};
        cur = nxt; cA0 = nA0; cA1 = nA1; cB = nB; ++ui;
#pragma unroll
        for (int h = 0; h < 2; ++h)
#pragma unroll
            for (int i = 0; i < 2; ++i) vA[h][i] = vAn[h][i];
        E.prefetch(cur, wc, fq, pre);
        if (GEMM_ALIGN) { if (wr == 1) G_BAR; }
    }
    G_WAIT_V(0);
    if (!GEMM_ALIGN) { if (wr == 0) G_BAR; }
    G_BAR;
#undef G_SA
#undef G_SB
#undef G_STAGE_A
#undef G_STAGE_B
#undef G_LDA
#undef G_LDB
#undef G_MMA
#undef G_WAIT_V
#undef G_WAIT_L
#undef G_BAR
#undef G_SCHED
#undef G_VOFF
#undef G_OPQ
}

struct DenseSched {
    const char* A; const char* B; int nM, nN, nwg, G, c, lda, K; size_t a_split_stride; int csplit;
    int L0 = 0, L1 = 0x7fffffff;
    int xtra = 0;
    __device__ void init(const void* A_, int lda_, const void* B_, int K_, int M, int N, int G_, int c_, int csplit_ = 0, size_t a_split_stride_ = 0) {
        A = (const char*)A_; B = (const char*)B_; lda = lda_; K = K_; nM = M / BM; nN = N / BM; nwg = nM * nN; G = G_; c = c_; csplit = csplit_; a_split_stride = a_split_stride_; }
    __device__ bool next(int i, GUnit& u) const {
        const long L = (long)L0 + (long)i * G + c; if (L >= nwg + xtra || L >= L1) return false;
        int pm, pn;
        if (L >= nwg) { const int j = (int)L - nwg, q = j >> 4; pm = nM + (j & 15); pn = q + 1 + (q >= 2 ? 1 : 0) + (q >= 10 ? 1 : 0); }
        else {
        int wgid = (int)L; { const int q = nwg / 8, r = nwg % 8, xcd = wgid % 8, off = wgid / 8; wgid = (xcd < r ? xcd * (q + 1) : r * (q + 1) + (xcd - r) * q) + off; }
        const int nig = DENSE_WGM * nN, gid = wgid / nig, fm = gid * DENSE_WGM, gsz = (nM - fm) < DENSE_WGM ? (nM - fm) : DENSE_WGM;
        pm = fm + ((wgid % nig) % gsz); pn = (wgid % nig) / gsz; }
        u.A0 = A + (csplit ? (size_t)(pn / csplit) * a_split_stride : 0) + (size_t)pm * BM * lda; u.A1 = u.A0 + (size_t)HALF * lda; u.B = B + (size_t)pn * BM * K * 2; u.rows = nullptr; u.nvalid = BM;
        u.rowbase = pm * BM; u.colbase = pn * BM; u.e = 0; u.pm = pm; return true;
    }
};
struct MergeSched {
    const char* A; const char* B; int nM, G, c; size_t a_stride;
    __device__ bool next(int i, GUnit& u) const {
        const int j = i / 3, br = i - 3 * j, nwg = nM * 4; const long L = (long)j * G + c; if (L >= nwg) return false;
        int wgid = (int)L; { const int q = nwg / 8, r = nwg % 8, xcd = wgid % 8, off = wgid / 8; wgid = (xcd < r ? xcd * (q + 1) : r * (q + 1) + (xcd - r) * q) + off; }
        const int nig = 8 * 4, gid = wgid / nig, fm = gid * 8, gsz = (nM - fm) < 8 ? (nM - fm) : 8;
        const int pm = fm + ((wgid % nig) % gsz), pn = (wgid % nig) / gsz;
        u.A0 = A + (size_t)br * a_stride + (size_t)pm * BM * 1024; u.A1 = u.A0 + (size_t)HALF * 1024; u.B = B + ((size_t)br * 1024 + pn * BM) * 512 * 2; u.rows = nullptr; u.nvalid = BM;
        u.rowbase = pm * BM; u.colbase = pn * BM; u.e = br; u.pm = pm; return true;
    }
};
struct MoeSched {
    const LAS int* pre; const LAS int* ps; const unsigned* cnt; const char* A; const char* B; const int* list; int nct, G, c, K, gather, lda;
    __device__ bool next(int i, GUnit& u) const {
        const int L = i * G + c; if (L >= pre[NEXP]) return false;
        int e = 0;
#pragma unroll 1
        for (int x = 1; x < NEXP; ++x) e = (L >= pre[x]) ? x : e;
        const int loc = L - pre[e], ce = ps[64 + e], pn = loc % nct, tile = loc / nct;
        u.e = e; u.rowbase = ps[e] + tile * BM; u.colbase = pn * BM; u.pm = tile; u.nvalid = ce - tile * BM;
        u.B = B + ((size_t)e * nct + pn) * BM * K * 2;
        if (gather) { u.A0 = A; u.A1 = A; u.rows = list + (size_t)e * NTOK + tile * BM; }
        else { u.A0 = A + (size_t)u.rowbase * lda; u.A1 = u.A0 + (size_t)HALF * lda; u.rows = nullptr; }
        return true;
    }
};
__device__ __forceinline__ void moe_tables(LAS int* pre, LAS int* ps, const unsigned* cnt, int nct, int wave) {
    if (lane_id() == 0 && wave == 0) { int a = 0, s = 0; for (int e = 0; e < NEXP; ++e) { const int c = (int)cnt[e]; pre[e] = a; ps[e] = s; ps[64 + e] = c; a += ((c + 255) >> 8) * nct; s += (c + 255) & ~255; } pre[NEXP] = a; }
    __syncthreads();
}

#define EPI_ARGS const f32x4 (&acc)[2][2][4][2], const GUnit& u, int wr, int wc, int fr, int fq
struct EpiNoPre {};
#define EPI_NOPRE typedef EpiNoPre Pre; __device__ __forceinline__ void prefetch(const GUnit&, int, int, Pre&) const {}
#define EPI_ROWS _Pragma("unroll") for (int ai = 0; ai < 2; ++ai) _Pragma("unroll") for (int m = 0; m < 4; ++m)
__device__ __forceinline__ u32x4 pack8(const f32x4& a, const f32x4& b) { u32x4 w; w.x = cvt_pk_bf16(a[0], a[1]); w.y = cvt_pk_bf16(a[2], a[3]); w.z = cvt_pk_bf16(b[0], b[1]); w.w = cvt_pk_bf16(b[2], b[3]); return w; }
__device__ __forceinline__ void unpack8(const u32x4& w, float (&o)[8]) {
    o[0] = __uint_as_float(w.x << 16); o[1] = __uint_as_float(w.x & 0xffff0000u); o[2] = __uint_as_float(w.y << 16); o[3] = __uint_as_float(w.y & 0xffff0000u);
    o[4] = __uint_as_float(w.z << 16); o[5] = __uint_as_float(w.z & 0xffff0000u); o[6] = __uint_as_float(w.w << 16); o[7] = __uint_as_float(w.w & 0xffff0000u); }

struct EpiWin { EPI_NOPRE static constexpr bool PERM = true; bf16* P;
    __device__ __forceinline__ void operator()(EPI_ARGS, const Pre&) const {
        EPI_ROWS { const int row = u.rowbase + ai * HALF + wr * 64 + m * 16 + fr; bf16* rowp = P + (size_t)row * LDP + u.colbase + wc * 32 + fq * 8;
#pragma unroll
            for (int bj = 0; bj < 2; ++bj) *(u32x4*)(rowp + bj * HALF) = pack8(acc[ai][bj][m][0], acc[ai][bj][m][1]); } } };

struct EpiQup { EPI_NOPRE static constexpr bool PERM = true; bf16* QM; const float* rq;
    __device__ __forceinline__ void operator()(EPI_ARGS, const Pre&) const {
        float r[2][4];
        EPI_ROWS r[ai][m] = rq[u.rowbase + ai * HALF + wr * 64 + m * 16 + fr];
        EPI_ROWS { const int row = u.rowbase + ai * HALF + wr * 64 + m * 16 + fr; bf16* rowp = QM + (size_t)row * 768 + u.colbase + wc * 32 + fq * 8;
#pragma unroll
            for (int bj = 0; bj < 2; ++bj) *(u32x4*)(rowp + bj * HALF) = pack8(acc[ai][bj][m][0] * r[ai][m], acc[ai][bj][m][1] * r[ai][m]); } } };

struct EpiKVup { EPI_NOPRE static constexpr bool PERM = true; bf16 *KM, *VM; const float* rkv;
    __device__ __forceinline__ void operator()(EPI_ARGS, const Pre&) const {
        float r[2][4];
        EPI_ROWS r[ai][m] = rkv[u.rowbase + ai * HALF + wr * 64 + m * 16 + fr];
        EPI_ROWS { const int row = u.rowbase + ai * HALF + wr * 64 + m * 16 + fr;
#pragma unroll
            for (int bj = 0; bj < 2; ++bj) { const int c8 = u.colbase + bj * HALF + wc * 32 + fq * 8, h = c8 >> 7, j = c8 & 127;
                bf16* dst = j < 64 ? KM + (size_t)row * 768 + h * 96 + j : VM + (size_t)row * 512 + h * 64 + (j - 64);
                *(u32x4*)dst = pack8(acc[ai][bj][m][0] * r[ai][m], acc[ai][bj][m][1] * r[ai][m]); } } } };

struct EpiMerge { EPI_NOPRE static constexpr bool PERM = true; bf16* Y; const bf16* P;
    template <bool ACC> __device__ __forceinline__ void body(EPI_ARGS) const {
        const int br = u.e;
#pragma unroll
        for (int ai = 0; ai < 2; ++ai) { u32x4 gt[4][2], pv[4][2];
#pragma unroll
            for (int m = 0; m < 4; ++m)
#pragma unroll
                for (int bj = 0; bj < 2; ++bj) { const int row = u.rowbase + ai * HALF + wr * 64 + m * 16 + fr, c8 = u.colbase + bj * HALF + wc * 32 + fq * 8;
                    gt[m][bj] = *(const u32x4*)(P + (size_t)row * LDP + C_GATE + br * D + c8);
                    if (ACC) pv[m][bj] = *(const u32x4*)(Y + (size_t)row * D + c8); }
#pragma unroll
            for (int m = 0; m < 4; ++m) { const int row = u.rowbase + ai * HALF + wr * 64 + m * 16 + fr;
#pragma unroll
                for (int bj = 0; bj < 2; ++bj) { const int c8 = u.colbase + bj * HALF + wc * 32 + fq * 8; float g[8], y0[8]; unpack8(gt[m][bj], g);
                    if (ACC) unpack8(pv[m][bj], y0);
                    f32x4 v0 = acc[ai][bj][m][0], v1 = acc[ai][bj][m][1];
#pragma unroll
                    for (int j = 0; j < 4; ++j) { v0[j] = v0[j] * sigmoidf_(g[j]) + (ACC ? y0[j] : 0.f); v1[j] = v1[j] * sigmoidf_(g[4 + j]) + (ACC ? y0[4 + j] : 0.f); }
                    *(u32x4*)(Y + (size_t)row * D + c8) = pack8(v0, v1); } } } }
    __device__ __forceinline__ void operator()(EPI_ARGS, const Pre&) const { if (u.e == 0) body<false>(acc, u, wr, wc, fr, fq); else body<true>(acc, u, wr, wc, fr, fq); } };

#ifndef XB_BF16
#define XB_BF16 1
#endif
#if XB_BF16 && !defined(XB_NOEPI)
struct EpiWout { EPI_NOPRE static constexpr bool PERM = true; Ptrs p; int l;
    __device__ __forceinline__ void operator()(EPI_ARGS, const Pre&) const {
        int goff = wc * 32 + fq * 8, xoff = (wr * 64 + fr) * D + wc * 32 + fq * 8;
        asm volatile("" : "+v"(goff), "+v"(xoff));
        const float* g1 = (const float*)(p.ws + WS_MOD) + ((size_t)l * 17 + mod_row(u.rowbase)) * 6 * D + 2 * D + u.colbase;
        bf16* xt = (bf16*)(p.ws + WS_XB) + (size_t)u.rowbase * D + u.colbase;
        f32x4 gv[2][2];
#pragma unroll
        for (int bj = 0; bj < 2; ++bj)
#pragma unroll
            for (int n = 0; n < 2; ++n) gv[bj][n] = *(const f32x4*)(g1 + goff + bj * HALF + n * 4);
#pragma unroll
        for (int ai = 0; ai < 2; ++ai) { u32x4 xv[4][2];
#pragma unroll
            for (int m = 0; m < 4; ++m)
#pragma unroll
                for (int bj = 0; bj < 2; ++bj) xv[m][bj] = *(const u32x4*)(xt + xoff + (ai * HALF + m * 16) * D + bj * HALF);
#pragma unroll
            for (int m = 0; m < 4; ++m)
#pragma unroll
                for (int bj = 0; bj < 2; ++bj) { float xo[8]; unpack8(xv[m][bj], xo);
                    const f32x4 o0 = (f32x4){xo[0], xo[1], xo[2], xo[3]} + gv[bj][0] * acc[ai][bj][m][0], o1 = (f32x4){xo[4], xo[5], xo[6], xo[7]} + gv[bj][1] * acc[ai][bj][m][1];
                    *(u32x4*)(xt + xoff + (ai * HALF + m * 16) * D + bj * HALF) = pack8(o0, o1); } } } };
#else
struct EpiWout { EPI_NOPRE static constexpr bool PERM = false; Ptrs p; int l;
    __device__ __forceinline__ void operator()(EPI_ARGS, const Pre&) const {
        const float* g1 = (const float*)(p.ws + WS_MOD) + ((size_t)l * 17 + mod_row(u.rowbase)) * 6 * D + 2 * D;
        const float* xs0 = (l == 0 ? (u.rowbase < NLAT ? p.x + (size_t)u.rowbase * D : p.ctx + (size_t)(u.rowbase - NLAT) * D) : (const float*)(p.ws + WS_XB) + (size_t)u.rowbase * D);
        f32x4 gv[2][2];
#pragma unroll
        for (int bj = 0; bj < 2; ++bj)
#pragma unroll
            for (int n = 0; n < 2; ++n) gv[bj][n] = *(const f32x4*)(g1 + u.colbase + bj * HALF + wc * 32 + n * 16 + fq * 4);
#pragma unroll
        for (int ai = 0; ai < 2; ++ai) { f32x4 xv[4][2][2];
#pragma unroll
            for (int m = 0; m < 4; ++m) { const float* xs = xs0 + (size_t)(ai * HALF + wr * 64 + m * 16 + fr) * D;
#pragma unroll
                for (int bj = 0; bj < 2; ++bj)
#pragma unroll
                    for (int n = 0; n < 2; ++n) xv[m][bj][n] = *(const f32x4*)(xs + u.colbase + bj * HALF + wc * 32 + n * 16 + fq * 4); }
#pragma unroll
            for (int m = 0; m < 4; ++m) { float* xb = (float*)(p.ws + WS_XB) + (size_t)(u.rowbase + ai * HALF + wr * 64 + m * 16 + fr) * D;
#pragma unroll
                for (int bj = 0; bj < 2; ++bj)
#pragma unroll
                    for (int n = 0; n < 2; ++n) *(f32x4*)(xb + u.colbase + bj * HALF + wc * 32 + n * 16 + fq * 4) = xv[m][bj][n] + gv[bj][n] * acc[ai][bj][m][n]; } } } };
#endif

struct EpiGu { static constexpr bool PERM = true; bf16* ACT; const float* b_gu;
    struct Pre { f32x4 bv[4]; };
    __device__ __forceinline__ void prefetch(const GUnit& u, int wc, int fq, Pre& pre) const {
        int lo = wc * 32 + fq * 8; asm volatile("" : "+v"(lo));
        const int ch8 = (u.colbase >> 1) + lo; const float* bp = b_gu + (size_t)u.e * 2 * DEXP + 2 * ch8;
#pragma unroll
        for (int q = 0; q < 4; ++q) pre.bv[q] = *(const f32x4*)(bp + 4 * q); }
    __device__ __forceinline__ void operator()(EPI_ARGS, const Pre& pre) const {
        const int ch8 = (u.colbase >> 1) + wc * 32 + fq * 8;
        EPI_ROWS { const int row = u.rowbase + ai * HALF + wr * 64 + m * 16 + fr; f32x4 o[2];
#pragma unroll
            for (int n = 0; n < 2; ++n)
#pragma unroll
                for (int j = 0; j < 4; ++j) { const int c = n * 4 + j; float g = acc[ai][0][m][n][j] + pre.bv[c >> 1][(c & 1) * 2], uu = acc[ai][1][m][n][j] + pre.bv[c >> 1][(c & 1) * 2 + 1];
                    g = fminf(g, 7.f); uu = fminf(fmaxf(uu, -7.f), 7.f); o[n][j] = (uu + 1.f) * (g * sigmoidf_(1.702f * g)); }
            *(u32x4*)(ACT + (size_t)row * DEXP + ch8) = pack8(o[0], o[1]); __builtin_amdgcn_sched_barrier(0); } } };

struct EpiDn { static constexpr bool PERM = true; bf16* YM; const float* b_dn;
    struct Pre { f32x4 bv[2][2]; };
    __device__ __forceinline__ void prefetch(const GUnit& u, int wc, int fq, Pre& pre) const {
#pragma unroll
        for (int bj = 0; bj < 2; ++bj) { int lo = wc * 32 + fq * 8; asm volatile("" : "+v"(lo));
            const float* bp = b_dn + (size_t)u.e * D + u.colbase + bj * HALF + lo; pre.bv[bj][0] = *(const f32x4*)bp; pre.bv[bj][1] = *(const f32x4*)(bp + 4); } }
    __device__ __forceinline__ void operator()(EPI_ARGS, const Pre& pre) const {
        EPI_ROWS { const int row = u.rowbase + ai * HALF + wr * 64 + m * 16 + fr;
#pragma unroll
            for (int bj = 0; bj < 2; ++bj) { const int c8 = u.colbase + bj * HALF + wc * 32 + fq * 8;
                *(u32x4*)(YM + (size_t)row * D + c8) = pack8(acc[ai][bj][m][0] + pre.bv[bj][0], acc[ai][bj][m][1] + pre.bv[bj][1]); } } } };

#define LDS_WAIT() asm volatile("s_waitcnt lgkmcnt(0)" ::: "memory")
struct ConvD { const float* W; const float* scale; bf16* WT; int ldw, ldd, koff, k0, n0, srccol, gu; };
__device__ __forceinline__ void conv_load(const ConvD& d, float (&v)[32], int lane) {
#pragma unroll
    for (int i = 0; i < 32; ++i) { const int kk = 2 * i + (lane >> 5); v[i] = d.srccol >= 0 ? d.W[(size_t)(d.k0 + kk) * d.ldw + d.srccol] : 0.f; }
}
__device__ __forceinline__ void conv_finish(const ConvD& d, const float (&v)[32], LAS float* scr, int lane) {
#pragma unroll
    for (int i = 0; i < 32; ++i) { const int kk = 2 * i + (lane >> 5); scr[kk * 33 + (lane & 31)] = d.scale ? v[i] * d.scale[d.k0 + kk] : v[i]; }
    LDS_WAIT();
    const int c = lane & 7;
#pragma unroll
    for (int j = 0; j < 4; ++j) { const int n = (lane >> 3) + 8 * j; const LAS float* s = scr + (8 * c) * 33 + n;
        u32x4 o; o.x = cvt_pk_bf16(s[0 * 33], s[1 * 33]); o.y = cvt_pk_bf16(s[2 * 33], s[3 * 33]); o.z = cvt_pk_bf16(s[4 * 33], s[5 * 33]); o.w = cvt_pk_bf16(s[6 * 33], s[7 * 33]);
        const int drow = d.gu ? d.n0 + (n & 1) * 128 + (n >> 1) : d.n0 + n;
        *(u32x4*)(d.WT + (size_t)drow * d.ldd + d.koff + d.k0 + 8 * c) = o; }
    LDS_WAIT();
}
__device__ __forceinline__ ConvD conv_dense_desc(const Ptrs& p, int it, int lane) {
    constexpr int I_WIN = 16 * 208, I_QUP = 6 * 24, I_KVUP = 4 * 32, I_BR = 8 * 32, I_OUT = 16 * 32;
    constexpr int PER_L = I_WIN + I_QUP + I_KVUP + 3 * I_BR + I_OUT;
    const int l = it / PER_L; int r = it % PER_L; ConvD d;
    if (r < I_WIN) { const int kb = r / 208, nb = r % 208, n = nb * 32 + (lane & 31);
        d = ConvD{p.w_in + (size_t)l * D * DIN, nullptr, (bf16*)(p.ws + WS_WIN) + (size_t)l * LDP * D, DIN, D, 0, kb * 64, nb * 32, n < DIN ? n : -1, 0}; return d; } r -= I_WIN;
    if (r < I_QUP) { const int kb = r / 24, nb = r % 24;
        d = ConvD{p.w_q_up + (size_t)l * 384 * 768, p.q_norm_g + l * 384, (bf16*)(p.ws + WS_WQUP) + (size_t)l * 768 * 384, 768, 384, 0, kb * 64, nb * 32, nb * 32 + (lane & 31), 0}; return d; } r -= I_QUP;
    if (r < I_KVUP) { const int kb = r / 32, nb = r % 32;
        d = ConvD{p.w_kv_up + (size_t)l * 256 * 1024, p.kv_norm_g + l * 256, (bf16*)(p.ws + WS_WKVUP) + (size_t)l * 1024 * 256, 1024, 256, 0, kb * 64, nb * 32, nb * 32 + (lane & 31), 0}; return d; } r -= I_KVUP;
    if (r < 3 * I_BR) { const int i = r / I_BR, q = r % I_BR, kb = q / 32, nb = q % 32;
        d = ConvD{p.w_branch + ((size_t)l * 3 + i) * 512 * D, nullptr, (bf16*)(p.ws + WS_WBR) + ((size_t)l * 3 + i) * D * 512, D, 512, 0, kb * 64, nb * 32, nb * 32 + (lane & 31), 0}; return d; } r -= 3 * I_BR;
    { const int kb = r / 32, nb = r % 32;
        d = ConvD{p.w_out + (size_t)l * D * D, nullptr, (bf16*)(p.ws + WS_WOUT) + (size_t)l * D * D, D, D, 0, kb * 64, nb * 32, nb * 32 + (lane & 31), 0}; return d; }
}
__device__ __forceinline__ ConvD conv_moe_desc(const Ptrs& p, int l, int it, int lane) {
    constexpr int I_GU = 16 * 64, I_DN = 16 * 32;
    const int e = it / (I_GU + I_DN); int r = it % (I_GU + I_DN);
    if (r < I_GU) { const int kb = r / 64, nb = r % 64;
        return ConvD{p.w_gu + ((size_t)l * NEXP + e) * D * 2 * DEXP, nullptr, (bf16*)(p.ws + WS_WGU) + (size_t)e * 2 * DEXP * D, 2 * DEXP, D, 0, kb * 64, (nb >> 3) * 256 + (nb & 7) * 16, nb * 32 + (lane & 31), 1}; }
    r -= I_GU; { const int kb = r / 32, nb = r % 32;
        return ConvD{p.w_dn + ((size_t)l * NEXP + e) * DEXP * D, nullptr, (bf16*)(p.ws + WS_WDN) + (size_t)e * D * DEXP, D, DEXP, 0, kb * 64, nb * 32, nb * 32 + (lane & 31), 0}; }
}
template <class DescF>
__device__ __forceinline__ void conv_run(int nitems, LAS float* scr, int gw, int NGW, int lane, const DescF& desc) {
    float v0[32], v1[32], v2[32], v3[32];
    ConvD d0, d1, d2, d3;
    int it = gw; if (it >= nitems) return;
    d0 = desc(it); d1 = d0; d2 = d0; d3 = d0;
    conv_load(d0, v0, lane);
    if (it + NGW < nitems) { d1 = desc(it + NGW); conv_load(d1, v1, lane); }
    if (it + 2 * NGW < nitems) { d2 = desc(it + 2 * NGW); conv_load(d2, v2, lane); }
    for (;;) {
        if (it + 3 * NGW < nitems) { d3 = desc(it + 3 * NGW); conv_load(d3, v3, lane); }
        conv_finish(d0, v0, scr, lane); it += NGW; if (it >= nitems) break;
        if (it + 3 * NGW < nitems) { d0 = desc(it + 3 * NGW); conv_load(d0, v0, lane); }
        conv_finish(d1, v1, scr, lane); it += NGW; if (it >= nitems) break;
        if (it + 3 * NGW < nitems) { d1 = desc(it + 3 * NGW); conv_load(d1, v1, lane); }
        conv_finish(d2, v2, scr, lane); it += NGW; if (it >= nitems) break;
        if (it + 3 * NGW < nitems) { d2 = desc(it + 3 * NGW); conv_load(d2, v2, lane); }
        conv_finish(d3, v3, scr, lane); it += NGW; if (it >= nitems) break;
    }
}
__device__ __forceinline__ void conv_dense_weights(const Ptrs& p, LAS float* scr, int gw, int NGW, int lane) {
    constexpr int PER_L = 16 * 208 + 6 * 24 + 4 * 32 + 3 * 8 * 32 + 16 * 32;
    conv_run(2 * PER_L, scr, gw, NGW, lane, [&](int it) { return conv_dense_desc(p, it, lane); });
}
__device__ __forceinline__ void conv_moe_weights(const Ptrs& p, int l, LAS float* scr, int gw, int NGW, int lane) {
    conv_run(NEXP * (16 * 64 + 16 * 32), scr, gw, NGW, lane, [&](int it) { return conv_moe_desc(p, l, it, lane); });
}
__device__ __forceinline__ void rope_tables(const Ptrs& p, int gtid, int NT) {
    float2* rs = (float2*)(p.ws + WS_ROPES); float2* rm = (float2*)(p.ws + WS_ROPEM);
    for (int i = gtid; i < SEQ * 32; i += NT) { const int t = i >> 5, j = i & 31; const float inv = powf(10000.f, -(float)(j & 15) / 16.f); const float ang = (j < 16 ? (float)(t / 64) : (float)(t % 64)) * inv; rs[i] = make_float2(cosf(ang), sinf(ang)); }
    for (int i = gtid; i < SEQ * 16; i += NT) { const int t = i >> 4, j = i & 15; const float inv = powf(10000.f, -(float)(j & 7) / 8.f); const float ang = (j < 8 ? (float)(t / 64) : (float)(t % 64)) * inv; rm[i] = make_float2(cosf(ang), sinf(ang)); }
}
__device__ __forceinline__ void mod_phase(const Ptrs& p, LAS float* lds, int G, int w) {
    LAS float* sc = lds;
    LAS float* red = lds + 1024 * 20;
    const int lane = lane_id(), tid = w * 64 + lane;
    for (int i = tid; i < 17 * D; i += NTHR) { const int r = i / D, k = i % D; const float v = r < NB ? p.c[(size_t)r * D + k] : p.c_ctx[k]; sc[k * 20 + r] = siluf_(v); }
    __syncthreads();
    for (int it = blockIdx.x; it < 2 * 96; it += G) { const int l = it / 96, n = (it % 96) * 64 + lane;
        const float* wm = p.w_mod + (size_t)l * D * 6 * D + n; float acc[17];
#pragma unroll
        for (int r = 0; r < 17; ++r) acc[r] = 0.f;
        float wv[128];
#pragma unroll
        for (int j = 0; j < 128; ++j) wv[j] = wm[(size_t)(w * 128 + j) * 6 * D];
#pragma unroll
        for (int j = 0; j < 128; ++j) { const LAS float* s = sc + (w * 128 + j) * 20;
#pragma unroll
            for (int r = 0; r < 17; ++r) acc[r] = fmaf(s[r], wv[j], acc[r]); }
#pragma unroll
        for (int r = 0; r < 17; ++r) red[(w * 17 + r) * 64 + lane] = acc[r];
        __syncthreads();
        for (int i = tid; i < 17 * 64; i += NTHR) { const int r = i >> 6, c = i & 63; float s = 0.f;
#pragma unroll
            for (int ww = 0; ww < 8; ++ww) s += red[(ww * 17 + r) * 64 + c];
            ((float*)(p.ws + WS_MOD))[((size_t)l * 17 + r) * 6 * D + (it % 96) * 64 + c] = s + p.b_mod[(size_t)l * 6 * D + (it % 96) * 64 + c]; }
        __syncthreads();
    }
}

__device__ __forceinline__ void norm1_rows2(const Ptrs& p, int l, int mode, int rowA, int rowB, int lane, const LAS int* ps) {
    const bool combine = (l > 0);
    const int rows[2] = {rowA, rowB < 0 ? rowA : rowB};
    float v[2][16], m[2][16];
#pragma unroll
    for (int q = 0; q < 2; ++q) {
#if XB_BF16 && !defined(XB_NON1L)
        if (l >= 1) { const bf16* src = (const bf16*)(p.ws + WS_XB) + (size_t)rows[q] * D;
#pragma unroll
            for (int j = 0; j < 4; ++j) { const uint2 t = *(const uint2*)(src + j * 256 + lane * 4);
                v[q][4 * j] = __uint_as_float(t.x << 16); v[q][4 * j + 1] = __uint_as_float(t.x & 0xffff0000u); v[q][4 * j + 2] = __uint_as_float(t.y << 16); v[q][4 * j + 3] = __uint_as_float(t.y & 0xffff0000u); } }
        else
#endif
        { const float* src = xrow_src(p, l >= 1 ? 1 : 0, rows[q]);
#pragma unroll
        for (int j = 0; j < 4; ++j) { const float4 t = *(const float4*)(src + j * 256 + lane * 4); v[q][4 * j] = t.x; v[q][4 * j + 1] = t.y; v[q][4 * j + 2] = t.z; v[q][4 * j + 3] = t.w; } } }
    if (combine) {
        const int lp = l - 1;
        int4 te[2], tp[2]; float4 tg[2];
#pragma unroll
        for (int q = 0; q < 2; ++q) { te[q] = *(const int4*)((const int*)(p.ws + WS_TOPE) + (size_t)rows[q] * 4); tp[q] = *(const int4*)((const int*)(p.ws + WS_TOPP) + (size_t)rows[q] * 4);
            tg[q] = *(const float4*)((const float*)(p.ws + WS_TOPG) + (size_t)rows[q] * 4); }
        uint2 yv[2][4][4];
#pragma unroll
        for (int q = 0; q < 2; ++q) { const int ee[4] = {te[q].x, te[q].y, te[q].z, te[q].w}, pp[4] = {tp[q].x, tp[q].y, tp[q].z, tp[q].w};
#pragma unroll
            for (int k = 0; k < 4; ++k) { const bf16* y = (const bf16*)(p.ws + WS_YM) + (size_t)(ps[ee[k]] + pp[k]) * D;
#pragma unroll
                for (int j = 0; j < 4; ++j) yv[q][k][j] = *(const uint2*)(y + j * 256 + lane * 4); } }
#pragma unroll
        for (int q = 0; q < 2; ++q) { const float gg[4] = {tg[q].x, tg[q].y, tg[q].z, tg[q].w};
            const float* modv = (const float*)(p.ws + WS_MOD) + ((size_t)lp * 17 + mod_row(rows[q])) * 6 * D + 5 * D;
#pragma unroll
            for (int i = 0; i < 16; ++i) m[q][i] = 0.f;
#pragma unroll
            for (int k = 0; k < 4; ++k)
#pragma unroll
                for (int j = 0; j < 4; ++j) { const uint2 t = yv[q][k][j]; const float g = gg[k];
                    m[q][4 * j] += g * __uint_as_float(t.x << 16); m[q][4 * j + 1] += g * __uint_as_float(t.x & 0xffff0000u); m[q][4 * j + 2] += g * __uint_as_float(t.y << 16); m[q][4 * j + 3] += g * __uint_as_float(t.y & 0xffff0000u); }
#pragma unroll
            for (int j = 0; j < 4; ++j) { const float4 g2 = *(const float4*)(modv + j * 256 + lane * 4);
                v[q][4 * j] += g2.x * m[q][4 * j]; v[q][4 * j + 1] += g2.y * m[q][4 * j + 1]; v[q][4 * j + 2] += g2.z * m[q][4 * j + 2]; v[q][4 * j + 3] += g2.w * m[q][4 * j + 3]; } }
#if !XB_BF16 || defined(XB_NON1S)
        if (mode != 2) {
#pragma unroll
            for (int q = 0; q < 2; ++q) if (q == 0 || rowB >= 0) { float* xb = (float*)(p.ws + WS_XB) + (size_t)rows[q] * D;
#pragma unroll
                for (int j = 0; j < 4; ++j) *(float4*)(xb + j * 256 + lane * 4) = make_float4(v[q][4 * j], v[q][4 * j + 1], v[q][4 * j + 2], v[q][4 * j + 3]); } }
#endif
    }
#if XB_BF16 && !defined(XB_NON1S)
    if (mode != 2) {
#pragma unroll
        for (int q = 0; q < 2; ++q) if (q == 0 || rowB >= 0) { bf16* xb = (bf16*)(p.ws + WS_XB) + (size_t)rows[q] * D;
#pragma unroll
            for (int j = 0; j < 4; ++j) *(uint2*)(xb + j * 256 + lane * 4) = make_uint2(cvt_pk_bf16(v[q][4 * j], v[q][4 * j + 1]), cvt_pk_bf16(v[q][4 * j + 2], v[q][4 * j + 3])); } }
#endif
    float r[2];
#pragma unroll
    for (int q = 0; q < 2; ++q) { float s = 0.f;
#pragma unroll
        for (int i = 0; i < 16; ++i) s += v[q][i] * v[q][i];
        r[q] = rsqrtf(wave_sum(s) * (1.f / D) + EPS); }
#pragma unroll
    for (int q = 0; q < 2; ++q) if (q == 0 || rowB >= 0) {
        if (mode == 2) {
            float* o = p.out + (size_t)rows[q] * D;
#pragma unroll
            for (int j = 0; j < 4; ++j) { const float4 g = *(const float4*)(p.final_g + j * 256 + lane * 4);
                *(float4*)(o + j * 256 + lane * 4) = make_float4(v[q][4 * j] * r[q] * g.x, v[q][4 * j + 1] * r[q] * g.y, v[q][4 * j + 2] * r[q] * g.z, v[q][4 * j + 3] * r[q] * g.w); }
        } else {
            const float* ng = p.norm1_g + (size_t)l * D;
            const float* modv = (const float*)(p.ws + WS_MOD) + ((size_t)l * 17 + mod_row(rows[q])) * 6 * D;
            bf16* h = (bf16*)(p.ws + WS_H) + (size_t)rows[q] * D;
#pragma unroll
            for (int j = 0; j < 4; ++j) { const int c = j * 256 + lane * 4; const float4 g = *(const float4*)(ng + c), sh = *(const float4*)(modv + c), sc = *(const float4*)(modv + D + c);
                *(uint2*)(h + c) = make_uint2(cvt_pk_bf16(v[q][4 * j] * r[q] * g.x * (1.f + sc.x) + sh.x, v[q][4 * j + 1] * r[q] * g.y * (1.f + sc.y) + sh.y),
                                              cvt_pk_bf16(v[q][4 * j + 2] * r[q] * g.z * (1.f + sc.z) + sh.z, v[q][4 * j + 3] * r[q] * g.w * (1.f + sc.w) + sh.w)); }
        }
    }
}

__device__ __forceinline__ void prep_row(const Ptrs& p, int l, int row, int lane) {
    const bf16* P = (const bf16*)(p.ws + WS_P) + (size_t)row * LDP;
    const bool lat = row < NLAT; const int t = lat ? row % SEQ : (row - NLAT) % CTXL, slen = lat ? SEQ : CTXL;
    { float s = 0.f;
#pragma unroll
      for (int j = 0; j < 6; ++j) { const float v = bf2f(P[C_CQ + lane + 64 * j]); s += v * v; }
      s = wave_sum(s); if (lane == 0) ((float*)(p.ws + WS_RQ))[row] = rsqrtf(s * (1.f / 384.f) + EPS);
      s = 0.f;
#pragma unroll
      for (int j = 0; j < 4; ++j) { const float v = bf2f(P[C_CKV + lane + 64 * j]); s += v * v; }
      s = wave_sum(s); if (lane == 0) ((float*)(p.ws + WS_RKV))[row] = rsqrtf(s * (1.f / 256.f) + EPS); }
    { bf16* QS = (bf16*)(p.ws + WS_QS) + (size_t)row * 512; bf16* KS = (bf16*)(p.ws + WS_KS) + (size_t)row * 128; const float2* rs = (const float2*)(p.ws + WS_ROPES) + (size_t)t * 32;
#pragma unroll
      for (int it = 0; it < 5; ++it) { const int pi = lane + 64 * it; const bool isq = pi < 256; const int hh = isq ? pi / 32 : (pi - 256) / 32, i = pi % 32;
        const bf16* src = P + (isq ? C_SQ : C_SK) + hh * 64; bf16* dst = (isq ? QS : KS) + hh * 64;
        const float x1 = bf2f(src[i]), x2 = bf2f(src[i + 32]); float2 cs = make_float2(1.f, 0.f); if (lat) cs = rs[i];
        dst[i] = f2bf(x1 * cs.x - x2 * cs.y); dst[i + 32] = f2bf(x2 * cs.x + x1 * cs.y); } }
    if (lane < 16) { const int i = lane; const float x1 = bf2f(P[C_KR + i]), x2 = bf2f(P[C_KR + i + 16]);
        float2 cs = make_float2(1.f, 0.f); if (lat) cs = ((const float2*)(p.ws + WS_ROPEM))[(size_t)t * 16 + i];
        const bf16 o1 = f2bf(x1 * cs.x - x2 * cs.y), o2 = f2bf(x2 * cs.x + x1 * cs.y);
        bf16* KM = (bf16*)(p.ws + WS_KM) + (size_t)row * 768;
#pragma unroll
        for (int h = 0; h < 8; ++h) { KM[h * 96 + 64 + i] = o1; KM[h * 96 + 80 + i] = o2; } }
    { const float* cw = p.conv_w + (size_t)l * 5 * 1536;
      bf16* DQ = (bf16*)(p.ws + WS_DQ) + (size_t)row * 512; bf16* DK = (bf16*)(p.ws + WS_DK) + (size_t)row * 512; bf16* DV = (bf16*)(p.ws + WS_DV) + (size_t)row * 512;
#pragma unroll 4
      for (int j = 0; j < 24; ++j) { const int c = lane + 64 * j; float y = 0.f;
#pragma unroll
        for (int tap = 0; tap < 5; ++tap) { const int tt = t + tap - 2; if (tt >= 0 && tt < slen) y += bf2f(P[(ptrdiff_t)(tap - 2) * LDP + C_DQKV + c]) * cw[tap * 1536 + c]; }
        y = siluf_(y);
        if (j < 16) { const float ss = wave_sum(y * y); y *= rsqrtf(ss + EPS); if (j < 8) y *= 0.125f; }
        if (j < 8) DQ[c] = f2bf(y); else if (j < 16) DK[c - 512] = f2bf(y); else DV[c - 1024] = f2bf(y); } }
    if (lane < 16) { const float braw = bf2f(P[C_DBETA + lane]), araw = bf2f(P[C_DA + lane]);
        ((float*)(p.ws + WS_DB))[(size_t)row * 16 + lane] = sigmoidf_(braw);
        ((float*)(p.ws + WS_DG))[(size_t)row * 16 + lane] = -__expf(p.a_log[l * 16 + lane]) * softplusf_(araw + p.dt_bias[l * 16 + lane]); }
}

__device__ __forceinline__ void dnpost_row(const Ptrs& p, int l, int row, int lane) {
    const bf16* o0 = (const bf16*)(p.ws + WS_DO) + (size_t)row * 512 + lane * 8; const bf16* o1 = o0 + (size_t)NTOK * 512;
    float fa[8], fb[8]; unpack8(*(const u32x4*)o0, fa); unpack8(*(const u32x4*)o1, fb);
    float v[8]; float s = 0.f;
#pragma unroll
    for (int i = 0; i < 8; ++i) v[i] = fa[i] + fb[i];
#pragma unroll
    for (int i = 0; i < 8; ++i) s += v[i] * v[i];
    s += __shfl_xor(s, 1); s += __shfl_xor(s, 2); s += __shfl_xor(s, 4);
    const float r = rsqrtf(s * (1.f / 64.f) + EPS);
    float z[8]; unpack8(*(const u32x4*)((const bf16*)(p.ws + WS_P) + (size_t)row * LDP + C_DZ + lane * 8), z); const float* ng = p.dn_norm_g + l * 64 + (lane & 7) * 8;
    float o[8];
#pragma unroll
    for (int i = 0; i < 8; ++i) o[i] = v[i] * r * ng[i] * siluf_(z[i]);
    u32x4 w; w.x = cvt_pk_bf16(o[0], o[1]); w.y = cvt_pk_bf16(o[2], o[3]); w.z = cvt_pk_bf16(o[4], o[5]); w.w = cvt_pk_bf16(o[6], o[7]);
    *(u32x4*)((bf16*)(p.ws + WS_BR) + (size_t)2 * NTOK * 512 + (size_t)row * 512 + lane * 8) = w;
}

#ifndef RTR_WREG
#define RTR_WREG 1
#endif
__device__ __forceinline__ void router_phase(const Ptrs& p, int l, int nrows, LAS unsigned char* lds, int G, int w) {
    LAS float* hrow = (LAS float*)lds;
    LAS unsigned* hist = (LAS unsigned*)(lds + 32768); LAS unsigned* base = hist + NEXP;
    LAS int* se = (LAS int*)(lds + 32768 + 256); LAS int* sp = se + 1024;
    const int lane = lane_id(), tid = w * 64 + lane;
    const int rpb = (nrows + G - 1) / G, r0 = blockIdx.x * rpb, r1 = min(nrows, r0 + rpb);
    if (tid < NEXP) hist[tid] = 0u;
    __syncthreads();
    const float* rw = p.router_w + (size_t)l * D * NEXP; const float* rb = p.router_b + l * NEXP;
    unsigned* cnt = (unsigned*)(p.ws + WS_CTL) + CW_CNT + 32 * l;
    int* TE = (int*)(p.ws + WS_TOPE); int* TP = (int*)(p.ws + WS_TOPP); float* TG = (float*)(p.ws + WS_TOPG);
    for (int row = r0 + w; row < r1; row += NWAVES) { const int rr = row - r0;
        const float* src = (const float*)(p.ws + WS_XB) + (size_t)row * D;
        float v[16]; float s = 0.f;
#pragma unroll
        for (int j = 0; j < 4; ++j) { const float4 t4 = *(const float4*)(src + j * 256 + lane * 4); v[4 * j] = t4.x; v[4 * j + 1] = t4.y; v[4 * j + 2] = t4.z; v[4 * j + 3] = t4.w; }
#pragma unroll
        for (int i = 0; i < 16; ++i) s += v[i] * v[i];
        const float r = rsqrtf(wave_sum(s) * (1.f / D) + EPS);
        const float* ng = p.norm2_g + (size_t)l * D; const float* modv = (const float*)(p.ws + WS_MOD) + ((size_t)l * 17 + mod_row(row)) * 6 * D + 3 * D;
        bf16* h = (bf16*)(p.ws + WS_H) + (size_t)row * D;
#pragma unroll
        for (int j = 0; j < 4; ++j) { const int c = j * 256 + lane * 4; const float4 g = *(const float4*)(ng + c), sh = *(const float4*)(modv + c), sc = *(const float4*)(modv + D + c);
            const float o0 = v[4 * j] * r * g.x * (1.f + sc.x) + sh.x, o1 = v[4 * j + 1] * r * g.y * (1.f + sc.y) + sh.y, o2 = v[4 * j + 2] * r * g.z * (1.f + sc.z) + sh.z, o3 = v[4 * j + 3] * r * g.w * (1.f + sc.w) + sh.w;
            *(LAS f32x4*)(hrow + w * D + c) = (f32x4){o0, o1, o2, o3};
            *(uint2*)(h + c) = make_uint2(cvt_pk_bf16(o0, o1), cvt_pk_bf16(o2, o3)); }
        LDS_WAIT();
        const int e = lane & 31, kh = lane >> 5; float acc = 0.f;
        const LAS float* hr = hrow + w * D + kh * 512; const float* rwp = rw + (size_t)kh * 512 * NEXP + e;
#pragma unroll 8
        for (int k = 0; k < 512; ++k) acc = fmaf(hr[k], rwp[(size_t)k * NEXP], acc);
        acc += __shfl_xor(acc, 32); acc += rb[e];
        float cur = acc, myv = 0.f, mx = 0.f, den = 0.f; int mye = 0;
#pragma unroll
        for (int k = 0; k < 4; ++k) { float bv = cur; int be = e;
#pragma unroll
            for (int o = 1; o < 32; o <<= 1) { const float ov = __shfl_xor(bv, o); const int oe = __shfl_xor(be, o); if (ov > bv || (ov == bv && oe < be)) { bv = ov; be = oe; } }
            if (k == 0) mx = bv;
            const float ex = __expf(bv - mx); den += ex;
            if (lane == k) { myv = ex; mye = be; }
            if (e == be) cur = -3.0e38f; }
        if (lane < 4) { const int k = lane;
            TE[(size_t)row * 4 + k] = mye; TG[(size_t)row * 4 + k] = myv / den; se[rr * 4 + k] = mye; sp[rr * 4 + k] = (int)__hip_atomic_fetch_add(&hist[mye], 1u, __ATOMIC_RELAXED, __HIP_MEMORY_SCOPE_WORKGROUP); }
    }
    __syncthreads();
    if (tid < NEXP) base[tid] = atomicAdd(&cnt[tid], hist[tid]);
    __syncthreads();
    int* LIST = (int*)(p.ws + WS_LIST);
    for (int i = tid; i < (r1 - r0) * 4; i += NTHR) { const int row = r0 + (i >> 2); const int e = se[i]; const int pos = sp[i] + (int)base[e];
        TP[(size_t)row * 4 + (i & 3)] = pos; LIST[(size_t)e * NTOK + pos] = row; }
    __syncthreads();
}

template <int DK, int MODE>
__device__ __forceinline__ void attn_wave(const Ptrs& p, int l, int ctxq, int qb, int h, int b, LAS float* wl, int lane) {
    constexpr int DV = 64, KT = 16;
    LAS float* Ks = wl; LAS float* Vs = wl + KT * DK;
    const int t = qb * 64 + lane, qrow = ctxq ? NLAT + b * CTXL + t : b * SEQ + t;
    const bf16* Qp = MODE == 0 ? (const bf16*)(p.ws + WS_QM) + (size_t)qrow * 768 + h * 96 : (const bf16*)(p.ws + WS_QS) + (size_t)qrow * 512 + h * 64;
    const float scale = MODE == 0 ? 0.10206207261596575f : 0.125f;
    float q[DK], o[DV];
#pragma unroll
    for (int i = 0; i < DK; ++i) q[i] = bf2f(Qp[i]) * scale;
#pragma unroll
    for (int i = 0; i < DV; ++i) o[i] = 0.f;
    float m = -1e30f, lsum = 0.f;
    if (MODE == 1) { m = p.sink[l * 8 + h]; lsum = 1.f; }
    if (MODE == 0 && !ctxq) { const float2* tab = (const float2*)(p.ws + WS_ROPEM) + (size_t)t * 16;
#pragma unroll
        for (int i = 0; i < 16; ++i) { const float2 cs = tab[i]; const float x1 = q[DK - 32 + i], x2 = q[DK - 16 + i]; q[DK - 32 + i] = x1 * cs.x - x2 * cs.y; q[DK - 16 + i] = x2 * cs.x + x1 * cs.y; } }
    for (int seg = 0; seg < (ctxq ? 1 : 2); ++seg) {
        int k0 = 0, k1 = CTXL; if (seg == 1) { k0 = 0; k1 = SEQ; if (MODE == 1) { k0 = max(0, qb * 64 - 128); k1 = min(SEQ, qb * 64 + 64 + 128); } }
        const int rbase = seg == 0 ? NLAT + b * CTXL : b * SEQ;
        for (int kt = k0; kt < k1; kt += KT) {
            LDS_WAIT();
            for (int e = lane; e < KT * DK; e += 64) { const int kk = e / DK, d = e % DK; const int row = rbase + kt + kk;
                Ks[kk * DK + d] = MODE == 0 ? bf2f(((const bf16*)(p.ws + WS_KM))[(size_t)row * 768 + h * 96 + d]) : bf2f(((const bf16*)(p.ws + WS_KS))[(size_t)row * 128 + (h >> 2) * 64 + d]); }
            for (int e = lane; e < KT * DV; e += 64) { const int kk = e / DV, d = e % DV; const int row = rbase + kt + kk;
                Vs[kk * DV + d] = MODE == 0 ? bf2f(((const bf16*)(p.ws + WS_VM))[(size_t)row * 512 + h * 64 + d]) : bf2f(((const bf16*)(p.ws + WS_P))[(size_t)row * LDP + C_SV + (h >> 2) * 64 + d]); }
            LDS_WAIT();
            for (int kk = 0; kk < KT; ++kk) {
                if (MODE == 1 && seg == 1) { const int dlt = kt + kk - t; if (dlt > 128 || dlt < -128) continue; }
                float s = 0.f;
#pragma unroll
                for (int i = 0; i < DK; ++i) s = fmaf(q[i], Ks[kk * DK + i], s);
                const float mn = fmaxf(m, s), c = __expf(m - mn), pe = __expf(s - mn);
                lsum = lsum * c + pe; m = mn;
#pragma unroll
                for (int i = 0; i < DV; ++i) o[i] = fmaf(pe, Vs[kk * DV + i], o[i] * c);
            }
        }
    }
    const float inv = 1.f / lsum;
    bf16* O = (bf16*)(p.ws + WS_BR) + (size_t)(MODE == 0 ? 0 : 1) * NTOK * 512 + (size_t)qrow * 512 + h * 64;
#pragma unroll
    for (int i = 0; i < DV; i += 2) *(unsigned*)(O + i) = cvt_pk_bf16(o[i] * inv, o[i + 1] * inv);
}
__device__ __forceinline__ void dn_scan_wave(const Ptrs& p, int b, int h, int dir, LAS float* wl, int v) {
    constexpr int CH = 16;
    LAS float* qs = wl; LAS float* ks = wl + CH * 64; LAS float* vs = wl + 2 * CH * 64; LAS float* gs = wl + 3 * CH * 64; LAS float* bs = gs + CH; LAS int* rs = (LAS int*)(bs + CH);
    float S[64];
#pragma unroll
    for (int i = 0; i < 64; ++i) S[i] = 0.f;
    float* DO = (float*)(p.ws + WS_DO) + (size_t)dir * NTOK * 512;
    for (int s0 = 0; s0 < CTXL + SEQ; s0 += CH) {
        LDS_WAIT();
        for (int e = v; e < CH * 64; e += 64) { const int i = e >> 6, d = e & 63; const int s = s0 + i;
            const int row = s < CTXL ? NLAT + b * CTXL + (dir ? CTXL - 1 - s : s) : b * SEQ + (dir ? SEQ - 1 - (s - CTXL) : (s - CTXL));
            qs[i * 64 + d] = bf2f(((const bf16*)(p.ws + WS_DQ))[(size_t)row * 512 + h * 64 + d]); ks[i * 64 + d] = bf2f(((const bf16*)(p.ws + WS_DK))[(size_t)row * 512 + h * 64 + d]);
            vs[i * 64 + d] = bf2f(((const bf16*)(p.ws + WS_DV))[(size_t)row * 512 + h * 64 + d]);
            if (d == 0) { rs[i] = row; gs[i] = ((const float*)(p.ws + WS_DG))[(size_t)row * 16 + dir * 8 + h]; bs[i] = ((const float*)(p.ws + WS_DB))[(size_t)row * 16 + dir * 8 + h]; } }
        LDS_WAIT();
        for (int i = 0; i < CH; ++i) {
            float kS = 0.f;
#pragma unroll
            for (int k = 0; k < 64; ++k) kS = fmaf(ks[i * 64 + k], S[k], kS);
            const float a = __expf(gs[i]), dl = bs[i] * (vs[i * 64 + v] - a * kS);
            float o = 0.f;
#pragma unroll
            for (int k = 0; k < 64; ++k) { S[k] = fmaf(ks[i * 64 + k], dl, a * S[k]); o = fmaf(qs[i * 64 + k], S[k], o); }
            DO[(size_t)rs[i] * 512 + h * 64 + v] = o;
        }
    }
}
__device__ __forceinline__ void mixers_valu_phase(const Ptrs& p, int l, LAS unsigned char* lds, int gw, int NGW, int wave, int lane) {
    LAS float* wl = (LAS float*)(lds + wave * 16384);
    const int n_lat = SEQ / 64 * 8 * NB, n_ctx = l == 0 ? CTXL / 64 * 8 * NB : 0;
    for (int r = gw; r < 256; r += NGW) dn_scan_wave(p, r & 15, (r >> 4) & 7, r >> 7, wl, lane);
    for (int r = gw; r < n_lat; r += NGW) attn_wave<96, 0>(p, l, 0, r & 31, (r >> 5) & 7, r >> 8, wl, lane);
    for (int r = gw; r < n_lat; r += NGW) attn_wave<64, 1>(p, l, 0, r & 31, (r >> 5) & 7, r >> 8, wl, lane);
    for (int r = gw; r < n_ctx; r += NGW) attn_wave<96, 0>(p, l, 1, r & 3, (r >> 2) & 7, r >> 5, wl, lane);
    for (int r = gw; r < n_ctx; r += NGW) attn_wave<64, 1>(p, l, 1, r & 3, (r >> 2) & 7, r >> 5, wl, lane);
}

__device__ __forceinline__ void prep_phase2(const Ptrs& p, int l, int gw, int NGW, int lane) {
    const bf16* Pb = (const bf16*)(p.ws + WS_P);
    constexpr int N_CONV = (NTOK / 64) * 3, N_MISC = NTOK / 16;
    for (int it = gw; it < N_CONV + N_MISC; it += NGW) {
        if (it < N_CONV) {
            const int part = it % 3, row0 = (it / 3) * 64; const bool lat = row0 < NLAT; const int t0 = lat ? row0 % SEQ : (row0 - NLAT) % CTXL, slen = lat ? SEQ : CTXL;
            const int c0 = part * 512 + lane * 8;
            float w[5][8];
#pragma unroll
            for (int tap = 0; tap < 5; ++tap) { const float4 a = *(const float4*)(p.conv_w + (size_t)l * 5 * 1536 + tap * 1536 + c0), b4 = *(const float4*)(p.conv_w + (size_t)l * 5 * 1536 + tap * 1536 + c0 + 4);
                w[tap][0] = a.x; w[tap][1] = a.y; w[tap][2] = a.z; w[tap][3] = a.w; w[tap][4] = b4.x; w[tap][5] = b4.y; w[tap][6] = b4.z; w[tap][7] = b4.w; }
            bf16* dst = (bf16*)(p.ws + (part == 0 ? WS_DQ : part == 1 ? WS_DK : WS_DV)) + lane * 8;
            for (int g8 = 0; g8 < 8; ++g8) {
                u32x4 xr[12];
#pragma unroll
                for (int j = 0; j < 12; ++j) { const int tt = t0 + g8 * 8 + j - 2; xr[j] = (u32x4){0u, 0u, 0u, 0u};
                    if (tt >= 0 && tt < slen) xr[j] = *(const u32x4*)(Pb + (size_t)(row0 + g8 * 8 + j - 2) * LDP + C_DQKV + c0); }
#pragma unroll
                for (int o = 0; o < 8; ++o) { float y[8];
#pragma unroll
                    for (int e = 0; e < 8; ++e) y[e] = 0.f;
#pragma unroll
                    for (int tap = 0; tap < 5; ++tap) { float x8[8]; unpack8(xr[o + tap], x8);
#pragma unroll
                        for (int e = 0; e < 8; ++e) y[e] = fmaf(x8[e], w[tap][e], y[e]); }
                    float ss = 0.f;
#pragma unroll
                    for (int e = 0; e < 8; ++e) { y[e] = siluf_(y[e]); ss += y[e] * y[e]; }
                    if (part < 2) { ss += __shfl_xor(ss, 1); ss += __shfl_xor(ss, 2); ss += __shfl_xor(ss, 4); const float rn = rsqrtf(ss + EPS) * (part == 0 ? 0.125f : 1.f);
#pragma unroll
                        for (int e = 0; e < 8; ++e) y[e] *= rn; }
                    u32x4 wv; wv.x = cvt_pk_bf16(y[0], y[1]); wv.y = cvt_pk_bf16(y[2], y[3]); wv.z = cvt_pk_bf16(y[4], y[5]); wv.w = cvt_pk_bf16(y[6], y[7]);
                    *(u32x4*)(dst + (size_t)(row0 + g8 * 8 + o) * 512) = wv; }
            }
        } else {
            const int row0 = (it - N_CONV) * 16; const bool lat = row0 < NLAT;
            for (int i0 = 0; i0 < 16; i0 += 4) {
                u32x4 ra[4], rb2[4], rq[4], rk[4], rr[4]; float gb[4], ga[4];
#pragma unroll
                for (int u = 0; u < 4; ++u) { const bf16* P = Pb + (size_t)(row0 + i0 + u) * LDP;
                    ra[u] = *(const u32x4*)(P + lane * 8); rb2[u] = *(const u32x4*)(P + 512 + (lane & 15) * 8);
                    rq[u] = *(const u32x4*)(P + C_SQ + lane * 8); rk[u] = *(const u32x4*)(P + C_SK + (lane & 15) * 8); rr[u] = *(const u32x4*)(P + C_KR + (lane & 3) * 8);
                    gb[u] = bf2f(P[C_DBETA + (lane & 15)]); ga[u] = bf2f(P[C_DA + (lane & 15)]); }
#pragma unroll
                for (int u = 0; u < 4; ++u) { const int row = row0 + i0 + u; const int t = lat ? row % SEQ : 0;
                    { float s8[8]; unpack8(ra[u], s8); float s1 = 0.f, s2 = 0.f, ssum = 0.f;
#pragma unroll
                      for (int e = 0; e < 8; ++e) ssum += s8[e] * s8[e];
                      if (lane < 48) s1 = ssum; else s2 = ssum;
                      if (lane < 16) { unpack8(rb2[u], s8);
#pragma unroll
                          for (int e = 0; e < 8; ++e) s2 += s8[e] * s8[e]; }
                      s1 = wave_sum(s1); s2 = wave_sum(s2);
                      if (lane == 0) { ((float*)(p.ws + WS_RQ))[row] = rsqrtf(s1 * (1.f / 384.f) + EPS); ((float*)(p.ws + WS_RKV))[row] = rsqrtf(s2 * (1.f / 256.f) + EPS); } }
                    { float x8[8], p8[8]; const u32x4 raw = rq[u]; unpack8(raw, x8);
                      u32x4 pr; pr.x = __shfl_xor(raw.x, 4); pr.y = __shfl_xor(raw.y, 4); pr.z = __shfl_xor(raw.z, 4); pr.w = __shfl_xor(raw.w, 4); unpack8(pr, p8);
                      const float2* rs = (const float2*)(p.ws + WS_ROPES) + (size_t)t * 32 + (lane & 3) * 8; const float sgn = (lane & 4) ? 1.f : -1.f; float o8[8]; float2 cs8[8];
#pragma unroll
                      for (int e = 0; e < 8; ++e) { cs8[e] = make_float2(1.f, 0.f); if (lat) cs8[e] = rs[e]; o8[e] = x8[e] * cs8[e].x + sgn * p8[e] * cs8[e].y; }
                      u32x4 wv; wv.x = cvt_pk_bf16(o8[0], o8[1]); wv.y = cvt_pk_bf16(o8[2], o8[3]); wv.z = cvt_pk_bf16(o8[4], o8[5]); wv.w = cvt_pk_bf16(o8[6], o8[7]);
                      *(u32x4*)((bf16*)(p.ws + WS_QS) + (size_t)row * 512 + lane * 8) = wv;
                      const u32x4 rawk = rk[u]; unpack8(rawk, x8);
                      pr.x = __shfl_xor(rawk.x, 4); pr.y = __shfl_xor(rawk.y, 4); pr.z = __shfl_xor(rawk.z, 4); pr.w = __shfl_xor(rawk.w, 4); unpack8(pr, p8);
#pragma unroll
                      for (int e = 0; e < 8; ++e) o8[e] = x8[e] * cs8[e].x + sgn * p8[e] * cs8[e].y;
                      wv.x = cvt_pk_bf16(o8[0], o8[1]); wv.y = cvt_pk_bf16(o8[2], o8[3]); wv.z = cvt_pk_bf16(o8[4], o8[5]); wv.w = cvt_pk_bf16(o8[6], o8[7]);
                      if (lane < 16) *(u32x4*)((bf16*)(p.ws + WS_KS) + (size_t)row * 128 + lane * 8) = wv; }
                    { const int ch = lane & 3; float x8[8], p8[8]; const u32x4 raw = rr[u]; unpack8(raw, x8);
                      u32x4 pr; pr.x = __shfl_xor(raw.x, 2); pr.y = __shfl_xor(raw.y, 2); pr.z = __shfl_xor(raw.z, 2); pr.w = __shfl_xor(raw.w, 2); unpack8(pr, p8);
                      const float2* rm = (const float2*)(p.ws + WS_ROPEM) + (size_t)t * 16 + (ch & 1) * 8; const float sgn = (ch & 2) ? 1.f : -1.f; float o8[8];
#pragma unroll
                      for (int e = 0; e < 8; ++e) { float2 cs = make_float2(1.f, 0.f); if (lat) cs = rm[e]; o8[e] = x8[e] * cs.x + sgn * p8[e] * cs.y; }
                      u32x4 wv; wv.x = cvt_pk_bf16(o8[0], o8[1]); wv.y = cvt_pk_bf16(o8[2], o8[3]); wv.z = cvt_pk_bf16(o8[4], o8[5]); wv.w = cvt_pk_bf16(o8[6], o8[7]);
                      if (lane < 32) *(u32x4*)((bf16*)(p.ws + WS_KM) + (size_t)row * 768 + (lane >> 2) * 96 + 64 + ch * 8) = wv; }
                    if (lane < 16) {
                        ((float*)(p.ws + WS_DB))[(size_t)row * 16 + lane] = sigmoidf_(gb[u]);
                        ((float*)(p.ws + WS_DG))[(size_t)row * 16 + lane] = -__expf(p.a_log[l * 16 + lane]) * softplusf_(ga[u] + p.dt_bias[l * 16 + lane]); }
                }
            }
        }
    }
}

__device__ __forceinline__ void router_phase2(const Ptrs& p, int l, int nrows, LAS unsigned char* lds, int G, int w) {
    constexpr int HST = 1028;
    LAS float* hs = (LAS float*)lds;
    LAS float* red = (LAS float*)(lds + 65792);
    LAS unsigned* hist = (LAS unsigned*)(lds + 98560); LAS unsigned* base = hist + NEXP;
    LAS int* se = (LAS int*)(lds + 98560 + 256); LAS int* sp = se + 1024;
    const int lane = lane_id(), tid = w * 64 + lane;
    const int rpb = (nrows + G - 1) / G, r0 = blockIdx.x * rpb, r1 = min(nrows, r0 + rpb);
    if (tid < NEXP) hist[tid] = 0u;
    __syncthreads();
    const float* rw = p.router_w + (size_t)l * D * NEXP; const float* rb = p.router_b + l * NEXP;
    unsigned* cnt = (unsigned*)(p.ws + WS_CTL) + CW_CNT + 32 * l;
    int* TE = (int*)(p.ws + WS_TOPE); int* TP = (int*)(p.ws + WS_TOPP); float* TG = (float*)(p.ws + WS_TOPG);
    const float* ng = p.norm2_g + (size_t)l * D;
#if RTR_WREG
    float rwv[64];
    { const int e_ = lane & 31, kb_ = 128 * w + 64 * (lane >> 5);
#pragma unroll
      for (int kk = 0; kk < 64; ++kk) rwv[kk] = rw[(size_t)(kb_ + kk) * NEXP + e_]; }
#endif
    for (int t0 = r0; t0 < r1; t0 += 16) {
        { float v[2][16];
#pragma unroll
          for (int q = 0; q < 2; ++q) { const int row = min(t0 + 2 * w + q, r1 - 1);
#if XB_BF16 && !defined(XB_NORTR)
              const bf16* src = (const bf16*)(p.ws + WS_XB) + (size_t)row * D;
#pragma unroll
              for (int j = 0; j < 4; ++j) { const uint2 t4 = *(const uint2*)(src + j * 256 + lane * 4);
                  v[q][4 * j] = __uint_as_float(t4.x << 16); v[q][4 * j + 1] = __uint_as_float(t4.x & 0xffff0000u); v[q][4 * j + 2] = __uint_as_float(t4.y << 16); v[q][4 * j + 3] = __uint_as_float(t4.y & 0xffff0000u); } }
#else
              const float* src = (const float*)(p.ws + WS_XB) + (size_t)row * D;
#pragma unroll
              for (int j = 0; j < 4; ++j) { const float4 t4 = *(const float4*)(src + j * 256 + lane * 4); v[q][4 * j] = t4.x; v[q][4 * j + 1] = t4.y; v[q][4 * j + 2] = t4.z; v[q][4 * j + 3] = t4.w; } }
#endif
#pragma unroll
          for (int q = 0; q < 2; ++q) { const int t = 2 * w + q, row = t0 + t;
            if (row < r1) {
                float s = 0.f;
#pragma unroll
                for (int i = 0; i < 16; ++i) s += v[q][i] * v[q][i];
                const float r = rsqrtf(wave_sum(s) * (1.f / D) + EPS);
                const float* modv = (const float*)(p.ws + WS_MOD) + ((size_t)l * 17 + mod_row(row)) * 6 * D + 3 * D;
                bf16* h = (bf16*)(p.ws + WS_H) + (size_t)row * D;
#pragma unroll
                for (int j = 0; j < 4; ++j) { const int c = j * 256 + lane * 4; const float4 g = *(const float4*)(ng + c), sh = *(const float4*)(modv + c), sc = *(const float4*)(modv + D + c);
                    const float o0 = v[q][4 * j] * r * g.x * (1.f + sc.x) + sh.x, o1 = v[q][4 * j + 1] * r * g.y * (1.f + sc.y) + sh.y, o2 = v[q][4 * j + 2] * r * g.z * (1.f + sc.z) + sh.z, o3 = v[q][4 * j + 3] * r * g.w * (1.f + sc.w) + sh.w;
                    *(LAS f32x4*)(hs + t * HST + c) = (f32x4){o0, o1, o2, o3};
                    *(uint2*)(h + c) = make_uint2(cvt_pk_bf16(o0, o1), cvt_pk_bf16(o2, o3)); }
            } else {
#pragma unroll
                for (int j = 0; j < 4; ++j) *(LAS f32x4*)(hs + t * HST + j * 256 + lane * 4) = (f32x4){0.f, 0.f, 0.f, 0.f}; } } }
        __syncthreads();
        { const int e = lane & 31, kh = lane >> 5, kb = 128 * w + 64 * kh; float acc[16];
#pragma unroll
          for (int t = 0; t < 16; ++t) acc[t] = 0.f;
#if RTR_WREG
#pragma unroll
          for (int kk = 0; kk < 64; ++kk) {
#pragma unroll
              for (int t = 0; t < 16; ++t) acc[t] = fmaf(hs[t * HST + kb + kk], rwv[kk], acc[t]); }
#else
#pragma unroll 4
          for (int kk = 0; kk < 64; ++kk) { const float wv = rw[(size_t)(kb + kk) * NEXP + e];
#pragma unroll
              for (int t = 0; t < 16; ++t) acc[t] = fmaf(hs[t * HST + kb + kk], wv, acc[t]); }
#endif
#pragma unroll
          for (int t = 0; t < 16; ++t) red[((w * 2 + kh) * 16 + t) * 32 + e] = acc[t]; }
        __syncthreads();
        { const int t = tid >> 5, e = tid & 31, row = t0 + t; float acc = rb[e];
#pragma unroll
          for (int q = 0; q < 16; ++q) acc += red[(q * 16 + t) * 32 + e];
          float cur = acc, myv = 0.f, mx = 0.f, den = 0.f; int mye = 0;
#pragma unroll
          for (int k = 0; k < 4; ++k) { float bv = cur; int be = e;
#pragma unroll
              for (int o = 1; o < 32; o <<= 1) { const float ov = __shfl_xor(bv, o); const int oe = __shfl_xor(be, o); if (ov > bv || (ov == bv && oe < be)) { bv = ov; be = oe; } }
              if (k == 0) mx = bv;
              const float ex = __expf(bv - mx); den += ex;
              if (e == k) { myv = ex; mye = be; }
              if (e == be) cur = -3.0e38f; }
          if (e < 4 && row < r1) { const int rr = row - r0;
              TE[(size_t)row * 4 + e] = mye; TG[(size_t)row * 4 + e] = myv / den; se[rr * 4 + e] = mye; sp[rr * 4 + e] = (int)__hip_atomic_fetch_add(&hist[mye], 1u, __ATOMIC_RELAXED, __HIP_MEMORY_SCOPE_WORKGROUP); } }
        __syncthreads();
    }
    if (tid < NEXP) base[tid] = atomicAdd(&cnt[tid], hist[tid]);
    __syncthreads();
    int* LIST = (int*)(p.ws + WS_LIST);
    for (int i = tid; i < (r1 - r0) * 4; i += NTHR) { const int row = r0 + (i >> 2); const int e = se[i]; const int pos = sp[i] + (int)base[e];
        TP[(size_t)row * 4 + (i & 3)] = pos; LIST[(size_t)e * NTOK + pos] = row; }
    __syncthreads();
}

typedef float f32x16 __attribute__((ext_vector_type(16)));
struct AttnUnit { int qrow0;
                  int tpos0;
                  int hq;
                  int ctxq;
                  int ctx_row0;
                  int lat_row0;
                  int k0, k1; };
template <int MODE>
__device__ __forceinline__ void attn_unit(const Ptrs& p, int l, LAS unsigned char* lds, const AttnUnit& U, int wave, int lane) {
    constexpr int DK = MODE == 0 ? 96 : 64, NS = DK / 16, KST = DK * 2 + 16, VST = 144, KBUF = 64 * KST, BUF = KBUF + 64 * VST;
    constexpr int KCH = DK / 8;
    constexpr float LOG2E = 1.4426950408889634f;
    const float sc = (MODE == 0 ? 0.10206207261596575f : 0.125f) * LOG2E;
    const int tid = wave * 64 + lane, r = lane & 31, hh = lane >> 5;
    const bf16* Kg; const bf16* Vg; int ldk, ldv;
    if (MODE == 0) { Kg = (const bf16*)(p.ws + WS_KM) + U.hq * 96; ldk = 768; Vg = (const bf16*)(p.ws + WS_VM) + U.hq * 64; ldv = 512; }
    else { Kg = (const bf16*)(p.ws + WS_KS) + (U.hq >> 2) * 64; ldk = 128; Vg = (const bf16*)(p.ws + WS_P) + C_SV + (U.hq >> 2) * 64; ldv = LDP; }
    bf16x8 qf[NS];
    { const bf16* qp = MODE == 0 ? (const bf16*)(p.ws + WS_QM) + (size_t)(U.qrow0 + r) * 768 + U.hq * 96 : (const bf16*)(p.ws + WS_QS) + (size_t)(U.qrow0 + r) * 512 + U.hq * 64;
#pragma unroll
      for (int s = 0; s < NS; ++s) qf[s] = *(const bf16x8*)(qp + 16 * s + 8 * hh);
      const bool rope = MODE == 0 && !U.ctxq;
      const float2* tab = (const float2*)(p.ws + WS_ROPEM) + (size_t)(U.tpos0 + r) * 16 + 8 * hh;
#pragma unroll
      for (int s = 0; s < NS; ++s) { if (rope && s >= NS - 2) continue;
#pragma unroll
          for (int j = 0; j < 8; ++j) qf[s][j] = (short)f2bf(bf2f((bf16)qf[s][j]) * sc); }
      if (rope) {
#pragma unroll
          for (int j = 0; j < 8; ++j) { const float2 cs = tab[j]; const float x1 = bf2f((bf16)qf[NS - 2][j]) * sc, x2 = bf2f((bf16)qf[NS - 1][j]) * sc;
              qf[NS - 2][j] = (short)f2bf(x1 * cs.x - x2 * cs.y); qf[NS - 1][j] = (short)f2bf(x2 * cs.x + x1 * cs.y); } } }
    f32x16 o0, o1;
#pragma unroll
    for (int i = 0; i < 16; ++i) { o0[i] = 0.f; o1[i] = 0.f; }
    f32x16 o2;
#pragma unroll
    for (int i = 0; i < 16; ++i) o2[i] = 0.f;
    float m = 0.f, lsink = MODE == 1 ? __builtin_amdgcn_exp2f(p.sink[l * 8 + U.hq] * LOG2E) : 0.f;
    const bf16x8 ones = {0x3F80, 0x3F80, 0x3F80, 0x3F80, 0x3F80, 0x3F80, 0x3F80, 0x3F80};
    const int nctx = CTXL / 64, nlat = U.ctxq ? 0 : (U.k1 - U.k0) / 64, ntiles = nctx + nlat;
    const int vrow = tid & 63, vch = tid >> 6, vpos = (vrow & ~12) | ((vrow & 4) << 1) | ((vrow & 8) >> 1);
    u32x4 kreg0, kreg1, vreg;
    const bool k2 = (tid + 512) < 64 * KCH;
#define A_TROW(ti) ((ti) < nctx ? U.ctx_row0 + (ti) * 64 : U.lat_row0 + U.k0 + ((ti) - nctx) * 64)
#define A_LOAD(ti) do { const int _tr = A_TROW(ti); \
        { const int c = tid; kreg0 = *(const u32x4*)(Kg + (size_t)(_tr + c / KCH) * ldk + (c % KCH) * 8); } \
        if (k2) { const int c = tid + 512; kreg1 = *(const u32x4*)(Kg + (size_t)(_tr + c / KCH) * ldk + (c % KCH) * 8); } \
        vreg = *(const u32x4*)(Vg + (size_t)(_tr + vrow) * ldv + vch * 8); } while (0)
#define A_STORE(buf) do { LAS unsigned char* kb = lds + (buf) * BUF; \
        { const int c = tid; *(LAS u32x4*)(kb + (c / KCH) * KST + (c % KCH) * 16) = kreg0; } \
        if (k2) { const int c = tid + 512; *(LAS u32x4*)(kb + (c / KCH) * KST + (c % KCH) * 16) = kreg1; } \
        LAS unsigned short* vb = (LAS unsigned short*)(kb + KBUF); const unsigned vv[4] = {vreg.x, vreg.y, vreg.z, vreg.w}; \
        _Pragma("unroll") for (int e = 0; e < 8; ++e) vb[(vch * 8 + e) * (VST / 2) + vpos] = (unsigned short)(e & 1 ? vv[e >> 1] >> 16 : vv[e >> 1] & 0xffffu); } while (0)
    A_LOAD(0); A_STORE(0);
    __syncthreads();
    for (int ti = 0; ti < ntiles; ++ti) {
        if (ti + 1 < ntiles) A_LOAD(ti + 1);
        const LAS unsigned char* kb = lds + (ti & 1) * BUF; const LAS unsigned char* vb = kb + KBUF;
        f32x16 st[2];
        { bf16x8 kf[2][NS];
#pragma unroll
          for (int kt = 0; kt < 2; ++kt)
#pragma unroll
              for (int s = 0; s < NS; ++s) kf[kt][s] = *(const LAS bf16x8*)(kb + (32 * kt + r) * KST + (16 * s + 8 * hh) * 2);
          __builtin_amdgcn_sched_barrier(0);
#pragma unroll
          for (int kt = 0; kt < 2; ++kt) {
#pragma unroll
              for (int i = 0; i < 16; ++i) st[kt][i] = 0.f;
#pragma unroll
              for (int s = 0; s < NS; ++s) st[kt] = __builtin_amdgcn_mfma_f32_32x32x16_bf16(kf[kt][s], qf[s], st[kt], 0, 0, 0); } }
        bf16x8 vf[4][2];
#pragma unroll
        for (int ks = 0; ks < 4; ++ks) { vf[ks][0] = *(const LAS bf16x8*)(vb + r * VST + (16 * ks + 8 * hh) * 2); vf[ks][1] = *(const LAS bf16x8*)(vb + (32 + r) * VST + (16 * ks + 8 * hh) * 2); }
        __builtin_amdgcn_sched_barrier(0);
        float tmax = -1e30f;
#pragma unroll
        for (int kt = 0; kt < 2; ++kt)
#pragma unroll
            for (int i = 0; i < 16; ++i) {
                if (MODE == 1 && ti >= nctx && (ti == nctx || ti == ntiles - 1)) { const int kpos = U.k0 + (ti - nctx) * 64 + 32 * kt + (i & 3) + 8 * (i >> 2) + 4 * hh; const int dlt = kpos - (U.tpos0 + r); if (dlt > 128 || dlt < -128) st[kt][i] = -1e30f; }
                tmax = fmaxf(tmax, st[kt][i]); }
        tmax = fmaxf(tmax, __shfl_xor(tmax, 32));
        if (__any(tmax > m + 60.f)) { const float mn = tmax > m + 60.f ? tmax : m, alpha = __builtin_amdgcn_exp2f(m - mn); m = mn; lsink *= alpha;
#pragma unroll
            for (int i = 0; i < 16; ++i) { o0[i] *= alpha; o1[i] *= alpha; o2[i] *= alpha; } }
        if (__all(m == 0.f)) {
#pragma unroll
            for (int kt = 0; kt < 2; ++kt)
#pragma unroll
                for (int i = 0; i < 16; ++i) st[kt][i] = __builtin_amdgcn_exp2f(st[kt][i]);
        } else {
#pragma unroll
            for (int kt = 0; kt < 2; ++kt)
#pragma unroll
                for (int i = 0; i < 16; ++i) st[kt][i] = __builtin_amdgcn_exp2f(st[kt][i] - m);
        }
#pragma unroll
        for (int ks = 0; ks < 4; ++ks) { u32x4 pw;
            pw.x = cvt_pk_bf16(st[ks >> 1][8 * (ks & 1) + 0], st[ks >> 1][8 * (ks & 1) + 1]); pw.y = cvt_pk_bf16(st[ks >> 1][8 * (ks & 1) + 2], st[ks >> 1][8 * (ks & 1) + 3]);
            pw.z = cvt_pk_bf16(st[ks >> 1][8 * (ks & 1) + 4], st[ks >> 1][8 * (ks & 1) + 5]); pw.w = cvt_pk_bf16(st[ks >> 1][8 * (ks & 1) + 6], st[ks >> 1][8 * (ks & 1) + 7]);
            const bf16x8 pf = __builtin_bit_cast(bf16x8, pw);
            o0 = __builtin_amdgcn_mfma_f32_32x32x16_bf16(vf[ks][0], pf, o0, 0, 0, 0); o1 = __builtin_amdgcn_mfma_f32_32x32x16_bf16(vf[ks][1], pf, o1, 0, 0, 0);
            o2 = __builtin_amdgcn_mfma_f32_32x32x16_bf16(ones, pf, o2, 0, 0, 0); }
        if (ti + 1 < ntiles) A_STORE((ti + 1) & 1);
        __syncthreads();
    }
#undef A_TROW
#undef A_LOAD
#undef A_STORE
    const float inv = 1.f / (o2[0] + lsink);
    bf16* O = (bf16*)(p.ws + WS_BR) + (size_t)(MODE == 0 ? 0 : 1) * NTOK * 512 + (size_t)(U.qrow0 + r) * 512 + U.hq * 64;
#pragma unroll
    for (int g = 0; g < 4; ++g) {
        *(u32x2*)(O + 8 * g + 4 * hh) = (u32x2){cvt_pk_bf16(o0[4 * g] * inv, o0[4 * g + 1] * inv), cvt_pk_bf16(o0[4 * g + 2] * inv, o0[4 * g + 3] * inv)};
        *(u32x2*)(O + 32 + 8 * g + 4 * hh) = (u32x2){cvt_pk_bf16(o1[4 * g] * inv, o1[4 * g + 1] * inv), cvt_pk_bf16(o1[4 * g + 2] * inv, o1[4 * g + 3] * inv)}; }
}
__device__ __forceinline__ void attn_phase(const Ptrs& p, int l, LAS unsigned char* lds, int G, int vcu, int wave, int lane) {
    const int n_ml = NB * 8 * (SEQ / 256), n_sl = NB * 2 * (SEQ / 64), n_mc = l == 0 ? NB * 8 : 0, n_sc = l == 0 ? NB * 2 * (CTXL / 64) : 0;
    for (int u = vcu; u < n_ml; u += G) { const int qb = u & 7, h = (u >> 3) & 7, b = u >> 6;
        AttnUnit U{b * SEQ + qb * 256 + wave * 32, qb * 256 + wave * 32, h, 0, NLAT + b * CTXL, b * SEQ, 0, SEQ}; attn_unit<0>(p, l, lds, U, wave, lane); }
    for (int u = vcu; u < n_sl; u += G) { const int pb = u & 31, kvh = (u >> 5) & 1, b = u >> 6; const int q0 = pb * 64 + (wave & 1) * 32;
        AttnUnit U{b * SEQ + q0, q0, kvh * 4 + (wave >> 1), 0, NLAT + b * CTXL, b * SEQ, max(0, pb * 64 - 128), min(SEQ, pb * 64 + 192)}; attn_unit<1>(p, l, lds, U, wave, lane); }
    for (int u = vcu; u < n_mc; u += G) { const int h = u & 7, b = u >> 3;
        AttnUnit U{NLAT + b * CTXL + wave * 32, 0, h, 1, NLAT + b * CTXL, b * SEQ, 0, 0}; attn_unit<0>(p, l, lds, U, wave, lane); }
    for (int u = vcu; u < n_sc; u += G) { const int pb = u & 3, kvh = (u >> 2) & 1, b = u >> 3; const int q0 = pb * 64 + (wave & 1) * 32;
        AttnUnit U{NLAT + b * CTXL + q0, 0, kvh * 4 + (wave >> 1), 1, NLAT + b * CTXL, b * SEQ, 0, 0}; attn_unit<1>(p, l, lds, U, wave, lane); }
}


constexpr int DN_NCH = (CTXL + SEQ) / 64, DN_REC = 40960;
constexpr size_t WS_GLB = WS_RQ + 768 * 1024;
__device__ __forceinline__ int dn_row(int b, int dir, int ci, int c) {
    if (ci < CTXL / 64) { const int pos = 64 * ci + c; return NLAT + b * CTXL + (dir ? CTXL - 1 - pos : pos); }
    const int pos = 64 * (ci - CTXL / 64) + c; return b * SEQ + (dir ? SEQ - 1 - pos : pos);
}
__device__ __forceinline__ int dn_perm(int col) { return (col & ~31) | (((col >> 2) & 3) << 3) | (((col >> 4) & 1) << 2) | (col & 3); }

__device__ __forceinline__ float rdlane(float v, int i) { return __int_as_float(__builtin_amdgcn_readlane(__float_as_int(v), i)); }
__device__ __forceinline__ void dn_prep_phase(const Ptrs& p, LAS unsigned char* lds, int G, int wave) {
    const int pr = wave & 3, wp = wave >> 2;
    LAS float* Lbuf = (LAS float*)(lds + pr * 32768);
    const bf16* DQ = (const bf16*)(p.ws + WS_DQ); const bf16* DK = (const bf16*)(p.ws + WS_DK); const bf16* DV = (const bf16*)(p.ws + WS_DV);
    for (int chain = blockIdx.x; chain < 256; chain += G) {
        const int b = chain & 15, h = (chain >> 4) & 7, dir = chain >> 7;
        const size_t hb = (size_t)h * 64; const int rs = dir ? -1 : 1;
        for (int rnd = -1; rnd < DN_NCH / 4; ++rnd) {
            const int lane = lane_id(), fr = lane & 15, g4 = lane >> 4;
            if (wp == 1) {
                if (rnd >= 0) {
                    const int ci = rnd * 4 + pr, row0 = dn_row(b, dir, ci, 0), rl = row0 + lane * rs;
                    unsigned char* rec = p.ws + WS_PREP + ((size_t)chain * DN_NCH + ci) * DN_REC; bf16* QD = (bf16*)rec + 4096; bf16* KDT = (bf16*)rec + 3 * 4096;
                    float g = ((const float*)(p.ws + WS_DG))[(size_t)rl * 16 + dir * 8 + h];
                    u32x4 dq4[8], dk4[8];
#pragma unroll
                    for (int rr = 0; rr < 8; ++rr) dq4[rr] = *(const u32x4*)(DQ + (size_t)(row0 + ((lane >> 3) + 8 * rr) * rs) * 512 + hb + 8 * (lane & 7));
#pragma unroll
                    for (int q = 0; q < 8; ++q) dk4[q] = *(const u32x4*)(DK + (size_t)rl * 512 + hb + 8 * q);
#pragma unroll
                    for (int o = 1; o < 64; o <<= 1) { const float t = __shfl_up(g, o); if (lane >= o) g += t; }
                    const float gc = g, egc = __expf(g), gl = rdlane(gc, 63);
#pragma unroll
                    for (int rr = 0; rr < 8; ++rr) { const int i = (lane >> 3) + 8 * rr, cc = lane & 7; const float sc = __shfl(egc, i);
                        float q8[8]; unpack8(dq4[rr], q8);
                        const int p0 = dn_perm(8 * cc), p1 = dn_perm(8 * cc + 4);
                        *(u32x2*)(QD + i * 64 + p0) = (u32x2){cvt_pk_bf16(q8[0] * sc, q8[1] * sc), cvt_pk_bf16(q8[2] * sc, q8[3] * sc)};
                        *(u32x2*)(QD + i * 64 + p1) = (u32x2){cvt_pk_bf16(q8[4] * sc, q8[5] * sc), cvt_pk_bf16(q8[6] * sc, q8[7] * sc)}; }
                    { const float sc = __expf(gl - gc); const int pc = dn_perm(lane);
#pragma unroll
                      for (int q = 0; q < 8; ++q) { float k8[8]; unpack8(dk4[q], k8);
#pragma unroll
                          for (int e = 0; e < 8; ++e) KDT[(8 * q + e) * 64 + pc] = f2bf(k8[e] * sc); } }
                }
                if (rnd + 1 < DN_NCH / 4) {
                    const int ci = (rnd + 1) * 4 + pr, row0 = dn_row(b, dir, ci, 0), rl = row0 + lane * rs;
                    LAS float* Ls = Lbuf + ((rnd + 1) & 1) * 4096;
                    bf16* AI = (bf16*)(p.ws + WS_PREP + ((size_t)chain * DN_NCH + ci) * DN_REC) + 2 * 4096;
                    float g = ((const float*)(p.ws + WS_DG))[(size_t)rl * 16 + dir * 8 + h]; const float bt = ((const float*)(p.ws + WS_DB))[(size_t)rl * 16 + dir * 8 + h];
                    bf16x8 kb[4][2];
#pragma unroll
                    for (int nj = 0; nj < 4; ++nj)
#pragma unroll
                        for (int s = 0; s < 2; ++s) kb[nj][s] = *(const bf16x8*)(DK + (size_t)(row0 + (16 * nj + fr) * rs) * 512 + hb + 32 * s + 8 * g4);
                    bf16x8 qa[4][2];
#pragma unroll
                    for (int mi = 0; mi < 4; ++mi)
#pragma unroll
                        for (int s = 0; s < 2; ++s) qa[mi][s] = *(const bf16x8*)(DQ + (size_t)(row0 + (16 * mi + fr) * rs) * 512 + hb + 32 * s + 8 * g4);
#pragma unroll
                    for (int o = 1; o < 64; o <<= 1) { const float t = __shfl_up(g, o); if (lane >= o) g += t; }
                    const float gc = g;
                    if (lane == 63) ((float*)(p.ws + WS_GLB))[chain * DN_NCH + ci] = __expf(gc);
                    float gcj[4];
#pragma unroll
                    for (int nj = 0; nj < 4; ++nj) gcj[nj] = __shfl(gc, 16 * nj + fr);
#pragma unroll
                    for (int mi = 0; mi < 4; ++mi) {
                        float gci[4], bti[4];
#pragma unroll
                        for (int e = 0; e < 4; ++e) { gci[e] = __shfl(gc, 16 * mi + 4 * g4 + e); bti[e] = __shfl(bt, 16 * mi + 4 * g4 + e); }
#pragma unroll
                        for (int nj = 0; nj < 4; ++nj) { f32x4 kk = {0.f, 0.f, 0.f, 0.f}, qk = {0.f, 0.f, 0.f, 0.f};
#pragma unroll
                            for (int s = 0; s < 2; ++s) { kk = __builtin_amdgcn_mfma_f32_16x16x32_bf16(kb[mi][s], kb[nj][s], kk, 0, 0, 0); qk = __builtin_amdgcn_mfma_f32_16x16x32_bf16(qa[mi][s], kb[nj][s], qk, 0, 0, 0); }
                            const int j = 16 * nj + fr;
#pragma unroll
                            for (int e = 0; e < 4; ++e) { const int i = 16 * mi + 4 * g4 + e; const float dec = __expf(fminf(gci[e] - gcj[nj], 0.f));
                                Ls[i * 64 + j] = i > j ? bti[e] * kk[e] * dec : 0.f;
                                AI[i * 64 + dn_perm(j)] = f2bf(i >= j ? qk[e] * dec : 0.f); } } }
                }
            } else if (rnd >= 0) {
                const int ci = rnd * 4 + pr, row0 = dn_row(b, dir, ci, 0), rl = row0 + lane * rs;
                const LAS float* Ls = Lbuf + (rnd & 1) * 4096;
                unsigned char* rec = p.ws + WS_PREP + ((size_t)chain * DN_NCH + ci) * DN_REC; bf16* NW = (bf16*)rec; bf16* UT = NW + 4 * 4096;
                float g = ((const float*)(p.ws + WS_DG))[(size_t)rl * 16 + dir * 8 + h]; const float bt = ((const float*)(p.ws + WS_DB))[(size_t)rl * 16 + dir * 8 + h];
                float x[64], y[64];
                { const __amdgpu_buffer_rsrc_t rv = __builtin_amdgcn_make_buffer_rsrc((void*)(DV + hb + (size_t)(dir ? row0 - 63 : row0) * 512), 0, 64 * 1024, 0x00020000);
                  const __amdgpu_buffer_rsrc_t rk = __builtin_amdgcn_make_buffer_rsrc((void*)(DK + hb + (size_t)(dir ? row0 - 63 : row0) * 512), 0, 64 * 1024, 0x00020000);
#pragma unroll
                  for (int i = 0; i < 64; ++i) { x[i] = bf2f((bf16)__builtin_amdgcn_raw_buffer_load_b16(rv, lane * 2, (dir ? 63 - i : i) * 1024, 0)); y[i] = bf2f((bf16)__builtin_amdgcn_raw_buffer_load_b16(rk, lane * 2, (dir ? 63 - i : i) * 1024, 0)); } }
#pragma unroll
                for (int o = 1; o < 64; o <<= 1) { const float t = __shfl_up(g, o); if (lane >= o) g += t; }
                { const float scw = bt * __expf(g);
#pragma unroll
                  for (int i = 0; i < 64; ++i) { x[i] *= rdlane(bt, i); y[i] *= rdlane(scw, i); } }
                constexpr int RG = 8, PF = 6;
                f32x4 ring[RG];
                int pi = 1, pj = 0, ps = 0, cs = 0;
#pragma unroll
                for (int k = 0; k < PF; ++k) { ring[ps % RG] = *(const LAS f32x4*)(Ls + pi * 64 + 4 * pj); ++ps; ++pj; if (pj >= (pi + 3) / 4) { ++pi; pj = 0; } }
#pragma unroll
                for (int i = 1; i < 64; ++i) {
                    f32x2 acc4[4] = {{x[i], y[i]}, {0.f, 0.f}, {0.f, 0.f}, {0.f, 0.f}};
#pragma unroll
                    for (int j4 = 0; j4 < (i + 3) / 4; ++j4) {
                        if (pi < 64) { ring[ps % RG] = *(const LAS f32x4*)(Ls + pi * 64 + 4 * pj); ++ps; ++pj; if (pj >= (pi + 3) / 4) { ++pi; pj = 0; } }
                        __builtin_amdgcn_sched_barrier(0);
                        const f32x4 lv = ring[cs % RG]; ++cs;
#pragma unroll
                        for (int e = 0; e < 4; ++e) { const int j = 4 * j4 + e; if (j < i) { const f32x2 l2 = {lv[e], lv[e]}, xy = {x[j], y[j]}; acc4[e] = __builtin_elementwise_fma(-l2, xy, acc4[e]); } } }
                    const f32x2 a2 = (acc4[0] + acc4[1]) + (acc4[2] + acc4[3]); x[i] = a2.x; y[i] = a2.y; }
#pragma unroll
                for (int q = 0; q < 8; ++q) { u32x4 w; w.x = cvt_pk_bf16(x[8 * q], x[8 * q + 1]); w.y = cvt_pk_bf16(x[8 * q + 2], x[8 * q + 3]); w.z = cvt_pk_bf16(x[8 * q + 4], x[8 * q + 5]); w.w = cvt_pk_bf16(x[8 * q + 6], x[8 * q + 7]);
                    *(u32x4*)(UT + lane * 64 + 8 * q) = w; }
                const int pc = dn_perm(lane);
#pragma unroll
                for (int i = 0; i < 64; ++i) NW[i * 64 + pc] = f2bf(-y[i]);
            }
            __syncthreads();
        }
    }
}

__device__ __forceinline__ void dn_scan_phase(const Ptrs& p, int l, LAS unsigned char* lds, int G, int wave) {
    constexpr int MST = 144, MBUF = 64 * MST, BUF = 5 * MBUF;
    const int lane = lane_id(), tid = wave * 64 + lane, fr = lane & 15, g4 = lane >> 4;
    for (int chain = blockIdx.x; chain < 256; chain += G) {
        const int b = chain & 15, h = (chain >> 4) & 7, dir = chain >> 7;
        const unsigned char* rec0 = p.ws + WS_PREP + (size_t)chain * DN_NCH * DN_REC;
        bf16* DO = (bf16*)(p.ws + WS_DO) + (size_t)dir * NTOK * 512 + h * 64 + wave * 16 + fr;
        u32x4 sr[2][5];
#define DN_LOAD(set, ci) do { _Pragma("unroll") for (int i = 0; i < 5; ++i) sr[set][i] = __builtin_nontemporal_load((const u32x4*)(rec0 + (size_t)(ci) * DN_REC + (size_t)(tid + 512 * i) * 16)); } while (0)
#define DN_STORE(set, buf) do { _Pragma("unroll") for (int i = 0; i < 5; ++i) { const int q = tid + 512 * i; *(LAS u32x4*)(lds + (buf) * BUF + (q >> 9) * MBUF + ((q & 511) >> 3) * MST + (q & 7) * 16) = sr[set][i]; } } while (0)
        f32x4 sacc[4];
#pragma unroll
        for (int m = 0; m < 4; ++m) sacc[m] = (f32x4){0.f, 0.f, 0.f, 0.f};
        const float glv = ((const float*)(p.ws + WS_GLB))[chain * DN_NCH + (lane < DN_NCH ? lane : 0)];
        DN_LOAD(0, 0); DN_LOAD(1, 1); DN_STORE(0, 0);
        __syncthreads();
        for (int ci2 = 0; ci2 < DN_NCH; ci2 += 2) {
#pragma unroll
        for (int par = 0; par < 2; ++par) { const int ci = ci2 + par;
            if (ci + 2 < DN_NCH) DN_LOAD(par, ci + 2);
            if (wave < 4) {
                const LAS unsigned char* mb = lds + (ci & 1) * BUF;
                const float gl = rdlane(glv, ci);
#define DN_FRAG(mat, m, s) (*(const LAS bf16x8*)(mb + (mat) * MBUF + (16 * (m) + fr) * MST + (32 * (s) + 8 * g4) * 2))
#define DN_BOP(dst, acc) do { _Pragma("unroll") for (int s = 0; s < 2; ++s) { const unsigned w0 = cvt_pk_bf16(acc[2 * s][0], acc[2 * s][1]), w1 = cvt_pk_bf16(acc[2 * s][2], acc[2 * s][3]), \
                    w2 = cvt_pk_bf16(acc[2 * s + 1][0], acc[2 * s + 1][1]), w3 = cvt_pk_bf16(acc[2 * s + 1][2], acc[2 * s + 1][3]); \
                    dst[s][0] = (short)(w0 & 0xffffu); dst[s][1] = (short)(w0 >> 16); dst[s][2] = (short)(w1 & 0xffffu); dst[s][3] = (short)(w1 >> 16); \
                    dst[s][4] = (short)(w2 & 0xffffu); dst[s][5] = (short)(w2 >> 16); dst[s][6] = (short)(w3 & 0xffffu); dst[s][7] = (short)(w3 >> 16); } } while (0)
                bf16x8 sB[2], vB[2];
                DN_BOP(sB, sacc);
                f32x4 vacc[4], oacc[4];
#pragma unroll
                for (int m = 0; m < 4; ++m) { const u32x2 u = *(const LAS u32x2*)(mb + 4 * MBUF + (wave * 16 + fr) * MST + (16 * m + 4 * g4) * 2);
                    vacc[m] = (f32x4){__uint_as_float(u.x << 16), __uint_as_float(u.x & 0xffff0000u), __uint_as_float(u.y << 16), __uint_as_float(u.y & 0xffff0000u)};
                    oacc[m] = (f32x4){0.f, 0.f, 0.f, 0.f}; }
                { bf16x8 fa[4][2], fb[4][2];
#pragma unroll
                  for (int m = 0; m < 4; ++m)
#pragma unroll
                      for (int s = 0; s < 2; ++s) { fa[m][s] = DN_FRAG(0, m, s); fb[m][s] = DN_FRAG(1, m, s); }
                  __builtin_amdgcn_sched_barrier(0);
#pragma unroll
                  for (int m = 0; m < 4; ++m)
#pragma unroll
                      for (int s = 0; s < 2; ++s) { vacc[m] = __builtin_amdgcn_mfma_f32_16x16x32_bf16(fa[m][s], sB[s], vacc[m], 0, 0, 0);
                          oacc[m] = __builtin_amdgcn_mfma_f32_16x16x32_bf16(fb[m][s], sB[s], oacc[m], 0, 0, 0); }
#pragma unroll
                  for (int m = 0; m < 4; ++m)
#pragma unroll
                      for (int s = 0; s < 2; ++s) { fa[m][s] = DN_FRAG(2, m, s); fb[m][s] = DN_FRAG(3, m, s); }
                  __builtin_amdgcn_sched_barrier(0);
                  DN_BOP(vB, vacc);
#pragma unroll
                  for (int m = 0; m < 4; ++m) { sacc[m] *= gl;
#pragma unroll
                      for (int s = 0; s < 2; ++s) { oacc[m] = __builtin_amdgcn_mfma_f32_16x16x32_bf16(fa[m][s], vB[s], oacc[m], 0, 0, 0);
                          sacc[m] = __builtin_amdgcn_mfma_f32_16x16x32_bf16(fb[m][s], vB[s], sacc[m], 0, 0, 0); } } }
                if (l == 0 || ci >= CTXL / 64) {
#pragma unroll
                    for (int m = 0; m < 4; ++m)
#pragma unroll
                        for (int e = 0; e < 4; ++e) DO[(size_t)dn_row(b, dir, ci, 16 * m + 4 * g4 + e) * 512] = (bf16)(cvt_pk_bf16(oacc[m][e], 0.f) & 0xffffu); }
            }
            if (ci + 1 < DN_NCH) DN_STORE(par ^ 1, par ^ 1);
            __syncthreads();
        } }
#undef DN_LOAD
#undef DN_STORE
#undef DN_FRAG
#undef DN_BOP
    }
}

#ifndef EN_PRO
#define EN_PRO 1
#endif
#ifndef EN_N1
#define EN_N1 1
#endif
#ifndef EN_WIN
#define EN_WIN 1
#endif
#ifndef EN_PREP
#define EN_PREP 1
#endif
#ifndef EN_UP
#define EN_UP 1
#endif
#ifndef EN_MIX
#define EN_MIX 1
#endif
#ifndef EN_DNP
#define EN_DNP 1
#endif
#ifndef EN_MRG
#define EN_MRG 1
#endif
#ifndef EN_WOUT
#define EN_WOUT 1
#endif
#ifndef EN_RTR
#define EN_RTR 1
#endif
#ifndef EN_GU
#define EN_GU 1
#endif
#ifndef EN_DN
#define EN_DN 1
#endif
#ifndef EN_FIN
#define EN_FIN 1
#endif
#ifndef REP_PRO
#define REP_PRO 1
#endif
#ifndef REP_N1
#define REP_N1 1
#endif
#ifndef REP_WIN
#define REP_WIN 1
#endif
#ifndef REP_PREP
#define REP_PREP 1
#endif
#ifndef REP_UP
#define REP_UP 1
#endif
#ifndef REP_MIX
#define REP_MIX 1
#endif
#ifndef REP_DNP
#define REP_DNP 1
#endif
#ifndef REP_MRG
#define REP_MRG 1
#endif
#ifndef REP_WOUT
#define REP_WOUT 1
#endif
#ifndef REP_RTR
#define REP_RTR 1
#endif
#ifndef REP_GU
#define REP_GU 1
#endif
#ifndef REP_DN
#define REP_DN 1
#endif
#ifndef REP_FIN
#define REP_FIN 1
#endif
#ifndef WIN_TAILU
#define WIN_TAILU 448
#endif
#ifndef WIN_NCV
#define WIN_NCV 64
#endif
#ifndef REP_SCAN
#define REP_SCAN 1
#endif
#ifndef REP_ATTN
#define REP_ATTN 1
#endif
#ifndef REP_DNPREP
#define REP_DNPREP 1
#endif
#ifndef DN_CHUNKED
#define DN_CHUNKED 1
#endif
#ifndef CTX_KV_ONLY
#define CTX_KV_ONLY 1
#endif
#ifndef MIX_SWAP
#define MIX_SWAP 2
#endif
#ifndef MIX_VALU
#define MIX_VALU 0
#endif
constexpr int NPH_L = 11, PH_FINAL = 1 + 2 * NPH_L, NPHASES = PH_FINAL + 1;
struct Args { Ptrs p; int ph_lo, ph_hi, bar_idx, pad; };

__global__ void __launch_bounds__(NTHR, 2) fwd(Args args) {
    extern __shared__ __attribute__((aligned(16))) unsigned char lds_raw[];
    LAS unsigned char* lds = (LAS unsigned char*)lds_raw;
#if defined(__HIP_DEVICE_COMPILE__)
#define PH_PTRS() const __attribute__((address_space(4))) Ptrs* _pk = (const __attribute__((address_space(4))) Ptrs*)__builtin_amdgcn_kernarg_segment_ptr(); asm volatile("" : "+s"(_pk)); const Ptrs p = *_pk
#else
#define PH_PTRS() const Ptrs p = args.p
#endif
    const int wave = __builtin_amdgcn_readfirstlane(threadIdx.x >> 6);
    const int G = gridDim.x, gw = blockIdx.x * NWAVES + wave, NGW = G * NWAVES;
    const int vcu = (G % 8 == 0) ? (int)(blockIdx.x % 8) * (G / 8) + (int)(blockIdx.x / 8) : (int)blockIdx.x;
    volatile LAS unsigned* MISC = (volatile LAS unsigned*)(lds + LDS_MISC_OFF);
    LAS int* TAB = (LAS int*)(lds + LDS_TAB_OFF);
    if (threadIdx.x < 256) MISC[threadIdx.x] = 0u;
    __syncthreads();
    XcdBarrier bar = xcd_barrier_post((unsigned*)(args.p.ws + WS_CTL) + CW_BAR + args.bar_idx * XCD_BAR_WORDS, MISC + 8);
    const int lo = args.ph_lo, hi = args.ph_hi;
#define IN(k) (lo <= (k) && (k) < hi)
#ifndef REP_BAR
#define REP_BAR 1
#endif
#define SEAM(k) do { if (IN(k) && IN((k) + 1)) for (int _rb = 0; _rb < REP_BAR; ++_rb) xcd_barrier(bar, wave); } while (0)

    if (EN_PRO && IN(0)) for (int _rep = 0; _rep < REP_PRO; ++_rep) { if (_rep) __syncthreads(); PH_PTRS();
        mod_phase(p, (LAS float*)lds, G, wave);
        const int lane = lane_id();
        rope_tables(p, blockIdx.x * NTHR + wave * 64 + lane, G * NTHR);
        conv_dense_weights(p, (LAS float*)(lds + wave * 16384), gw, NGW, lane);
    }
    SEAM(0);
    for (int l = 0; l < 2; ++l) {
        const int pb = 1 + NPH_L * l, nq = l == 0 ? NTOK : NLAT;
        if (EN_N1 && IN(pb + 0)) for (int _rep = 0; _rep < REP_N1; ++_rep) { if (_rep) __syncthreads(); PH_PTRS();
            const int lane = lane_id();
            if (l > 0) moe_tables(TAB, TAB + 64, (const unsigned*)(p.ws + WS_CTL) + CW_CNT + 32 * (l - 1), 1, wave);
            for (int row = gw; row < NTOK; row += 2 * NGW) norm1_rows2(p, l, 0, row, row + NGW < NTOK ? row + NGW : -1, lane, TAB + 64);
        }
        SEAM(pb + 0);
        if (EN_WIN && IN(pb + 1)) for (int _rep = 0; _rep < REP_WIN; ++_rep) { if (_rep) __syncthreads(); PH_PTRS();
            const int ncv = (G >= 64 && G % 8 == 0) ? WIN_NCV : 0;
            const int xtra = (CTX_KV_ONLY && l == 1) ? (NCTX / BM) * 11 : 0, mrows = xtra ? NLAT : NTOK;
            const int nunits = (mrows / BM) * (LDP / BM) + xtra, ntail = ncv ? WIN_TAILU : 0;
            const bool cvt = (int)blockIdx.x >= G - ncv;
            if (cvt) { conv_moe_weights(p, l, (LAS float*)(lds + wave * 16384), ((int)blockIdx.x - (G - ncv)) * NWAVES + wave, ncv * NWAVES, lane_id()); __syncthreads(); }
            { DenseSched S; S.init(p.ws + WS_H, D * 2, p.ws + WS_WIN + (size_t)l * LDP * D * 2, D, mrows, LDP, cvt ? ncv : G - ncv, cvt ? (int)blockIdx.x - (G - ncv) : (int)blockIdx.x);
              S.xtra = xtra;
              if (cvt) S.L0 = nunits - ntail; else S.L1 = nunits - ntail;
              EpiWin E{(bf16*)(p.ws + WS_P)};
              gemm_phase<EpiWin, DenseSched, false>(lds, D, D * 2, S, E, wave); }
            if (ncv == 0) conv_moe_weights(p, l, (LAS float*)(lds + wave * 16384), gw, NGW, lane_id());
        }
        SEAM(pb + 1);
        if (EN_PREP && IN(pb + 2)) for (int _rep = 0; _rep < REP_PREP; ++_rep) { if (_rep) __syncthreads(); PH_PTRS(); prep_phase2(p, l, gw, NGW, lane_id()); }
        SEAM(pb + 2);
        if (EN_UP && IN(pb + 3)) for (int _rep = 0; _rep < REP_UP; ++_rep) { if (_rep) __syncthreads(); PH_PTRS();
            { DenseSched S; S.init(p.ws + WS_P + C_CQ * 2, LDP * 2, p.ws + WS_WQUP + (size_t)l * 768 * 384 * 2, 384, NTOK, 768, G, blockIdx.x);
              EpiQup E{(bf16*)(p.ws + WS_QM), (const float*)(p.ws + WS_RQ)};
              gemm_phase<EpiQup, DenseSched, false>(lds, 384, LDP * 2, S, E, wave); }
            { const int kvc = ((int)blockIdx.x + ((G - (NTOK / BM * 3) % G) / 8) * 8) % G;
              DenseSched S; S.init(p.ws + WS_P + C_CKV * 2, LDP * 2, p.ws + WS_WKVUP + (size_t)l * 1024 * 256 * 2, 256, NTOK, 1024, G, kvc);
              EpiKVup E{(bf16*)(p.ws + WS_KM), (bf16*)(p.ws + WS_VM), (const float*)(p.ws + WS_RKV)};
              gemm_phase<EpiKVup, DenseSched, false>(lds, 256, LDP * 2, S, E, wave); }
#if DN_CHUNKED
            for (int _r2 = 0; _r2 < REP_DNPREP; ++_r2) dn_prep_phase(p, lds, G, wave);
#endif
        }
        SEAM(pb + 3);
        if (EN_MIX && IN(pb + 4)) for (int _rep = 0; _rep < REP_MIX; ++_rep) { if (_rep) __syncthreads(); PH_PTRS();
#if MIX_VALU
            mixers_valu_phase(p, l, lds, gw, NGW, wave, lane_id());
#else
#if DN_CHUNKED
#if MIX_SWAP
            { int par = MIX_SWAP == 2 ? ((int)blockIdx.x & 1) : MIX_SWAP == 3 ? (vcu & 1) : (vcu >> 3) & 1; asm volatile("" : "+s"(par));
#pragma unroll 1
              for (int s_ = 0; s_ < 2; ++s_) { if ((s_ ^ par) == 0) dn_scan_phase(p, l, lds, G, wave); else attn_phase(p, l, lds, G, vcu, wave, lane_id()); __syncthreads(); } }
#else
            for (int _r2 = 0; _r2 < REP_SCAN; ++_r2) dn_scan_phase(p, l, lds, G, wave);
#endif
#else
            { const int lane = lane_id(); for (int r = gw; r < 256; r += NGW) dn_scan_wave(p, r & 15, (r >> 4) & 7, r >> 7, (LAS float*)(lds + wave * 16384), lane); }
            __syncthreads();
#endif
#if !MIX_SWAP
            for (int _r2 = 0; _r2 < REP_ATTN; ++_r2) attn_phase(p, l, lds, G, vcu, wave, lane_id());
#endif
#endif
        }
        SEAM(pb + 4);
        if (EN_DNP && IN(pb + 5)) for (int _rep = 0; _rep < REP_DNP; ++_rep) { if (_rep) __syncthreads(); PH_PTRS(); const int lane = lane_id(); for (int row = gw; row < nq; row += NGW) dnpost_row(p, l, row, lane); }
        SEAM(pb + 5);
        if (EN_MRG && IN(pb + 6)) for (int _rep = 0; _rep < REP_MRG; ++_rep) { if (_rep) __syncthreads(); PH_PTRS();
            MergeSched S{(const char*)(p.ws + WS_BR), (const char*)(p.ws + WS_WBR + (size_t)l * 3072 * 512 * 2), nq / BM, G, (int)blockIdx.x, (size_t)NTOK * 512 * 2};
            EpiMerge E{(bf16*)(p.ws + WS_YB), (const bf16*)(p.ws + WS_P)};
            gemm_phase<EpiMerge, MergeSched, false>(lds, 512, 512 * 2, S, E, wave);
        }
        SEAM(pb + 6);
        if (EN_WOUT && IN(pb + 7)) for (int _rep = 0; _rep < REP_WOUT; ++_rep) { if (_rep) __syncthreads(); PH_PTRS();
            DenseSched S; S.init(p.ws + WS_YB, D * 2, p.ws + WS_WOUT + (size_t)l * D * D * 2, D, nq, D, G, blockIdx.x);
            EpiWout E{p, l};
            gemm_phase<EpiWout, DenseSched, false>(lds, D, D * 2, S, E, wave);
        }
        SEAM(pb + 7);
        if (EN_RTR && IN(pb + 8)) for (int _rep = 0; _rep < REP_RTR; ++_rep) { if (_rep) __syncthreads(); PH_PTRS(); router_phase2(p, l, nq, lds, G, wave); }
        SEAM(pb + 8);
        if (EN_GU && IN(pb + 9)) for (int _rep = 0; _rep < REP_GU; ++_rep) { if (_rep) __syncthreads(); PH_PTRS();
            const unsigned* cnt = (const unsigned*)(p.ws + WS_CTL) + CW_CNT + 32 * l;
            moe_tables(TAB, TAB + 64, cnt, 8, wave);
            MoeSched S{TAB, TAB + 64, cnt, (const char*)(p.ws + WS_H), (const char*)(p.ws + WS_WGU), (const int*)(p.ws + WS_LIST), 8, G, vcu, D, 1, D * 2};
            EpiGu E{(bf16*)(p.ws + WS_ACT), p.b_gu + (size_t)l * NEXP * 2 * DEXP};
            gemm_phase<EpiGu, MoeSched, true>(lds, D, D * 2, S, E, wave);
        }
        SEAM(pb + 9);
        if (EN_DN && IN(pb + 10)) for (int _rep = 0; _rep < REP_DN; ++_rep) { if (_rep) __syncthreads(); PH_PTRS();
            const unsigned* cnt = (const unsigned*)(p.ws + WS_CTL) + CW_CNT + 32 * l;
            moe_tables(TAB, TAB + 64, cnt, 4, wave);
            MoeSched S{TAB, TAB + 64, cnt, (const char*)(p.ws + WS_ACT), (const char*)(p.ws + WS_WDN), nullptr, 4, G, vcu, DEXP, 0, DEXP * 2};
            EpiDn E{(bf16*)(p.ws + WS_YM), p.b_dn + (size_t)l * NEXP * D};
            gemm_phase<EpiDn, MoeSched, false>(lds, DEXP, DEXP * 2, S, E, wave);
        }
        SEAM(pb + 10);
    }
    if (EN_FIN && IN(PH_FINAL)) for (int _rep = 0; _rep < REP_FIN; ++_rep) { if (_rep) __syncthreads(); PH_PTRS();
        const int lane = lane_id();
        moe_tables(TAB, TAB + 64, (const unsigned*)(p.ws + WS_CTL) + CW_CNT + 32, 1, wave);
        for (int row = gw; row < NLAT; row += 2 * NGW) norm1_rows2(p, 2, 2, row, row + NGW < NLAT ? row + NGW : -1, lane, TAB + 64);
    }
#undef IN
#undef SEAM
}

#ifndef MEGA_MASK
#define MEGA_MASK 0x1fff
#endif
static int phase_kind(int ph) { if (ph == 0) return 0; if (ph == PH_FINAL) return 12; return 1 + (ph - 1) % NPH_L; }
static void simple_phase(const Ptrs& p, hipStream_t st, int ph) {
    unsigned char* ws = p.ws;
    if (ph == 0) { hipLaunchKernelGGL(k_mod, dim3(6 * D / 256, 17, 2), dim3(256), 0, st, p); return; }
    if (ph == PH_FINAL) { hipLaunchKernelGGL(k_norm1, dim3(NLAT / 4), dim3(256), 0, st, p, 2, NLAT, 2); return; }
    const int l = (ph - 1) / NPH_L, k = (ph - 1) % NPH_L, nq = l == 0 ? NTOK : NLAT;
    switch (k) {
    case 0: hipLaunchKernelGGL(k_norm1, dim3(NTOK / 4), dim3(256), 0, st, p, l, NTOK, 0); break;
    case 1: run_sgemm(st, NTOK, DIN, D, ABf{(const bf16*)(ws + WS_H), D, 0}, WF32{p.w_in + (size_t)l * D * DIN, DIN, 0}, EStoreBf{(bf16*)(ws + WS_P), LDP, 0}); break;
    case 2: hipLaunchKernelGGL(k_prep, dim3(NTOK / 4), dim3(256), 0, st, p, l); break;
    case 3:
        run_sgemm(st, NTOK, 768, 384, ABfG{(const bf16*)(ws + WS_P) + C_CQ, p.q_norm_g + l * 384, LDP, 0}, WF32{p.w_q_up + (size_t)l * 384 * 768, 768, 0}, EQup{(bf16*)(ws + WS_QM), (const float*)(ws + WS_RQ)});
        run_sgemm(st, NTOK, 1024, 256, ABfG{(const bf16*)(ws + WS_P) + C_CKV, p.kv_norm_g + l * 256, LDP, 0}, WF32{p.w_kv_up + (size_t)l * 256 * 1024, 1024, 0},
                  EKVup{(bf16*)(ws + WS_KM), (bf16*)(ws + WS_VM), (const float*)(ws + WS_RKV)});
        break;
    case 4:
        hipLaunchKernelGGL((k_attn<96, 0>), dim3(SEQ / 64, 8, NB), dim3(64), 0, st, p, l, 0);
        if (l == 0) hipLaunchKernelGGL((k_attn<96, 0>), dim3(CTXL / 64, 8, NB), dim3(64), 0, st, p, l, 1);
        hipLaunchKernelGGL((k_attn<64, 1>), dim3(SEQ / 64, 8, NB), dim3(64), 0, st, p, l, 0);
        if (l == 0) hipLaunchKernelGGL((k_attn<64, 1>), dim3(CTXL / 64, 8, NB), dim3(64), 0, st, p, l, 1);
        hipLaunchKernelGGL(k_dn_scan, dim3(NB, 8, 2), dim3(64), 0, st, p);
        break;
    case 5: hipLaunchKernelGGL(k_dn_post, dim3(nq / 4), dim3(256), 0, st, p, l, nq); break;
    case 6:
        for (int i = 0; i < 3; ++i)
            run_sgemm(st, nq, D, 512, ABf{(const bf16*)(ws + WS_BR) + (size_t)i * NTOK * 512, 512, 0}, WF32{p.w_branch + ((size_t)l * 3 + i) * 512 * D, D, 0},
                      EMerge{(float*)(ws + WS_YF), (bf16*)(ws + WS_YB), (const bf16*)(ws + WS_P), i, 0});
        break;
    case 7: run_sgemm(st, nq, D, D, ABf{(const bf16*)(ws + WS_YB), D, 0}, WF32{p.w_out + (size_t)l * D * D, D, 0}, EWout{p, l, 0}); break;
    case 8: hipLaunchKernelGGL(k_norm2_router, dim3(nq / R2_ROWS), dim3(256), 0, st, p, l, nq); break;
    case 9: hipLaunchKernelGGL(k_moe_gu, dim3(2 * DEXP / 128, NTOK * 4 / 128 + NEXP), dim3(256), 0, st, p, l); break;
    case 10: hipLaunchKernelGGL(k_moe_dn, dim3(D / 128, NTOK * 4 / 128 + NEXP), dim3(256), 0, st, p, l); break;
    }
}
extern "C" void kernel_launch(void* const* d_in, const int* in_sizes, int n_in, void* d_out, int out_size, void* d_ws, size_t ws_size, hipStream_t stream) {
    static int grid = 0;
    if (grid == 0) {
        if (n_in != 27 || ws_size < WS_END2) { fprintf(stderr, "kernel_launch: unexpected n_in %d / ws %zu (need %zu)\n", n_in, ws_size, (size_t)WS_END2); grid = -1; return; }
        int dev = 0, cus = 0, per_cu = 0;
        if (hipGetDevice(&dev) != hipSuccess || hipDeviceGetAttribute(&cus, hipDeviceAttributeMultiprocessorCount, dev) != hipSuccess) { grid = -1; return; }
        if (hipFuncSetAttribute((const void*)fwd, hipFuncAttributeMaxDynamicSharedMemorySize, LDS_BYTES) != hipSuccess) { fprintf(stderr, "kernel_launch: hipFuncSetAttribute failed\n"); grid = -1; return; }
        if (hipOccupancyMaxActiveBlocksPerMultiprocessor(&per_cu, (const void*)fwd, NTHR, LDS_BYTES) != hipSuccess || per_cu < 1) { fprintf(stderr, "kernel_launch: occupancy query says %d\n", per_cu); }
        (void)hipGetLastError();
        grid = cus;
    }
    if (grid < 0) return;
    const Ptrs p = make_ptrs(d_in, d_out, d_ws);
    (void)hipMemsetAsync((char*)d_ws + WS_CTL, 0, CTL_BYTES, stream);
    int bar_idx = 0;
    bool need_pro = false;
    for (int k = 1; k < 13; ++k) if ((MEGA_MASK >> k) & 1) need_pro = true;
    for (int ph = 0; ph < NPHASES;) {
        const int kind = phase_kind(ph);
        const bool mega = ((MEGA_MASK >> kind) & 1) || (ph == 0 && need_pro);
        if (!mega) { simple_phase(p, stream, ph); ++ph; continue; }
        int hi = ph + 1;
        while (hi < NPHASES && ((MEGA_MASK >> phase_kind(hi)) & 1)) ++hi;
        Args a{}; a.p = p; a.ph_lo = ph; a.ph_hi = hi; a.bar_idx = bar_idx++; a.pad = 0;
        hipLaunchKernelGGL(fwd, dim3(grid), dim3(NTHR), LDS_BYTES, stream, a);
        if (ph == 0 && !((MEGA_MASK >> 0) & 1)) simple_phase(p, stream, 0);
        ph = hi;
    }
}
```

```cpp
#include <hip/hip_runtime.h>
#include <cstdint>
#include <cstdio>

typedef unsigned short bf16;
constexpr int D = 1024, NB = 16, SEQ = 2048, CTXL = 256, NLAT = NB * SEQ, NCTX = NB * CTXL, NTOK = NLAT + NCTX;
constexpr int DIN = 6592, LDP = 6656;
constexpr int C_CQ = 0, C_CKV = 384, C_KR = 640, C_SQ = 672, C_SK = 1184, C_SV = 1312, C_DQKV = 1440, C_DZ = 2976, C_DBETA = 3488, C_DA = 3504, C_GATE = 3520;
constexpr int NEXP = 32, TOPK = 4, DEXP = 1024;
constexpr int MAXSLOT = NTOK * TOPK + NEXP * 256;
constexpr float EPS = 1e-6f;

constexpr size_t MiB = 1u << 20;
constexpr size_t WS_CTL = 0, CTL_BYTES = 1 * MiB;
constexpr size_t WS_MOD = 1 * MiB, WS_RQ = 2 * MiB, WS_RKV = 2 * MiB + 512 * 1024, WS_DG = 3 * MiB, WS_DB = 6 * MiB;
constexpr size_t WS_TOPE = 9 * MiB, WS_TOPG = 10 * MiB, WS_TOPP = 11 * MiB, WS_LIST = 12 * MiB;
constexpr size_t WS_WIN = 17 * MiB, WS_WQUP = 43 * MiB, WS_WKVUP = 45 * MiB, WS_WBR = 46 * MiB, WS_WOUT = 52 * MiB, WS_WGU = 56 * MiB, WS_WDN = 184 * MiB;
constexpr size_t WS_XB = 248 * MiB, WS_H = 392 * MiB, WS_YB = 464 * MiB;
constexpr size_t WS_P = 536 * MiB, WS_QM = 1004 * MiB, WS_KM = 1058 * MiB, WS_VM = 1112 * MiB, WS_QS = 1148 * MiB, WS_KS = 1184 * MiB;
constexpr size_t WS_ACT = 536 * MiB, WS_YM = 840 * MiB;
constexpr size_t WS_DQ = 1193 * MiB, WS_DK = 1229 * MiB, WS_DV = 1265 * MiB, WS_DO = 1301 * MiB, WS_BR = 1445 * MiB, WS_PREP = 1553 * MiB, WS_YF = 1553 * MiB;
constexpr size_t WS_END = 1913 * MiB;
static_assert(WS_YM + (size_t)MAXSLOT * 1024 * 2 <= WS_DQ, "moe overlay");
constexpr int CW_CNT = 64;
constexpr int CW_BAR = 4096;

__device__ __forceinline__ float bf2f(bf16 v) { return __uint_as_float(((unsigned)v) << 16); }
__device__ __forceinline__ bf16 f2bf(float f) { unsigned u = __float_as_uint(f); return (bf16)((u + 0x7fffu + ((u >> 16) & 1u)) >> 16); }
__device__ __forceinline__ unsigned pk2(float lo, float hi) { return (unsigned)f2bf(lo) | ((unsigned)f2bf(hi) << 16); }
__device__ __forceinline__ float wave_sum(float v) {
#pragma unroll
    for (int o = 1; o < 64; o <<= 1) v += __shfl_xor(v, o);
    return v;
}
__device__ __forceinline__ float sigmoidf_(float x) { return __builtin_amdgcn_rcpf(1.f + __builtin_amdgcn_exp2f(-1.4426950408889634f * x)); }
__device__ __forceinline__ float siluf_(float x) { return x * __builtin_amdgcn_rcpf(1.f + __builtin_amdgcn_exp2f(-1.4426950408889634f * x)); }
__device__ __forceinline__ float softplusf_(float x) { return x > 20.f ? x : log1pf(__expf(x)); }
__device__ __forceinline__ int mod_row(int row) { return row < NLAT ? row / SEQ : NB; }

struct Ptrs {
    const float *x, *c, *ctx, *c_ctx, *w_mod, *b_mod, *norm1_g, *norm2_g, *w_in, *q_norm_g, *w_q_up, *kv_norm_g, *w_kv_up, *sink, *conv_w, *a_log, *dt_bias, *dn_norm_g,
        *w_branch, *w_out, *router_w, *router_b, *w_gu, *b_gu, *w_dn, *b_dn, *final_g;
    float* out; unsigned char* ws;
};

__global__ void k_mod(Ptrs p) {
    const int n = blockIdx.x * 256 + threadIdx.x, r = blockIdx.y, l = blockIdx.z;
    const float* cv = r < NB ? p.c + (size_t)r * D : p.c_ctx;
    const float* w = p.w_mod + (size_t)l * D * 6 * D;
    float acc = 0.f;
    for (int k = 0; k < D; ++k) acc += siluf_(cv[k]) * w[(size_t)k * 6 * D + n];
    ((float*)(p.ws + WS_MOD))[((size_t)l * 17 + r) * 6 * D + n] = acc + p.b_mod[(size_t)l * 6 * D + n];
}

__device__ __forceinline__ const float* xrow_src(const Ptrs& p, int l, int row) {
    if (l == 0) return row < NLAT ? p.x + (size_t)row * D : p.ctx + (size_t)(row - NLAT) * D;
    return (const float*)(p.ws + WS_XB) + (size_t)row * D;
}

__global__ __launch_bounds__(256) void k_norm1(Ptrs p, int l, int nrows, int mode) {
    const int lane = threadIdx.x & 63, row = blockIdx.x * 4 + (threadIdx.x >> 6);
    if (row >= nrows) return;
    const bool combine = (l > 0);
    const float* src = xrow_src(p, l == 2 ? 1 : l, row);
    if (l == 2) src = (const float*)(p.ws + WS_XB) + (size_t)row * D;
    float v[16];
#pragma unroll
    for (int j = 0; j < 4; ++j) { const float4 t = *(const float4*)(src + j * 256 + lane * 4); v[4 * j] = t.x; v[4 * j + 1] = t.y; v[4 * j + 2] = t.z; v[4 * j + 3] = t.w; }
    if (combine) {
        const int lp = l - 1;
        const float* modv = (const float*)(p.ws + WS_MOD) + ((size_t)lp * 17 + mod_row(row)) * 6 * D + 5 * D;
        const int* tope = (const int*)(p.ws + WS_TOPE) + (size_t)row * 4; const int* topp = (const int*)(p.ws + WS_TOPP) + (size_t)row * 4;
        const float* topg = (const float*)(p.ws + WS_TOPG) + (size_t)row * 4;
        const unsigned* cnt = (const unsigned*)(p.ws + WS_CTL) + CW_CNT + 32 * lp;
        float m[16];
#pragma unroll
        for (int i = 0; i < 16; ++i) m[i] = 0.f;
        for (int k = 0; k < 4; ++k) {
            const int e = tope[k]; int ps = 0;
            for (int e2 = 0; e2 < e; ++e2) ps += (int)((cnt[e2] + 255u) & ~255u);
            const bf16* y = (const bf16*)(p.ws + WS_YM) + (size_t)(ps + topp[k]) * D; const float g = topg[k];
#pragma unroll
            for (int j = 0; j < 4; ++j) { const uint2 t = *(const uint2*)(y + j * 256 + lane * 4);
                m[4 * j] += g * bf2f((bf16)(t.x & 0xffff)); m[4 * j + 1] += g * bf2f((bf16)(t.x >> 16)); m[4 * j + 2] += g * bf2f((bf16)(t.y & 0xffff)); m[4 * j + 3] += g * bf2f((bf16)(t.y >> 16)); }
        }
#pragma unroll
        for (int j = 0; j < 4; ++j)
#pragma unroll
            for (int i = 0; i < 4; ++i) v[4 * j + i] += modv[j * 256 + lane * 4 + i] * m[4 * j + i];
        if (mode != 2) { float* xb = (float*)(p.ws + WS_XB) + (size_t)row * D;
#pragma unroll
            for (int j = 0; j < 4; ++j) *(float4*)(xb + j * 256 + lane * 4) = make_float4(v[4 * j], v[4 * j + 1], v[4 * j + 2], v[4 * j + 3]); }
    }
    float s = 0.f;
#pragma unroll
    for (int i = 0; i < 16; ++i) s += v[i] * v[i];
    const float r = rsqrtf(wave_sum(s) * (1.f / D) + EPS);
    if (mode == 2) {
        float* o = p.out + (size_t)row * D;
#pragma unroll
        for (int j = 0; j < 4; ++j) { const float4 g = *(const float4*)(p.final_g + j * 256 + lane * 4);
            *(float4*)(o + j * 256 + lane * 4) = make_float4(v[4 * j] * r * g.x, v[4 * j + 1] * r * g.y, v[4 * j + 2] * r * g.z, v[4 * j + 3] * r * g.w); }
        return;
    }
    const float* ng = p.norm1_g + (size_t)l * D;
    const float* modv = (const float*)(p.ws + WS_MOD) + ((size_t)l * 17 + mod_row(row)) * 6 * D;
    bf16* h = (bf16*)(p.ws + WS_H) + (size_t)row * D;
#pragma unroll
    for (int j = 0; j < 4; ++j) { float o[4];
#pragma unroll
        for (int i = 0; i < 4; ++i) { const int c = j * 256 + lane * 4 + i; o[i] = v[4 * j + i] * r * ng[c] * (1.f + modv[D + c]) + modv[c]; }
        *(uint2*)(h + j * 256 + lane * 4) = make_uint2(pk2(o[0], o[1]), pk2(o[2], o[3])); }
}

template <class AF, class WF, class EF>
__device__ __forceinline__ void sgemm_tile(int M, int N, int K, int tm, int tn, const AF& af, const WF& wf, const EF& ef, float (*As)[132], float (*Ws)[132]) {
    const int tx = threadIdx.x & 15, ty = threadIdx.x >> 4;
    float acc[8][8];
#pragma unroll
    for (int i = 0; i < 8; ++i)
#pragma unroll
        for (int j = 0; j < 8; ++j) acc[i][j] = 0.f;
    for (int k0 = 0; k0 < K; k0 += 16) {
#pragma unroll
        for (int j = 0; j < 8; ++j) { const int e = threadIdx.x + 256 * j; const int r = e >> 4, kk = e & 15; As[kk][r] = (tm + r < M) ? af(tm + r, k0 + kk) : 0.f; }
#pragma unroll
        for (int j = 0; j < 8; ++j) { const int e = threadIdx.x + 256 * j; const int kk = e >> 7, n = e & 127; Ws[kk][n] = (tn + n < N) ? wf(k0 + kk, tn + n) : 0.f; }
        __syncthreads();
#pragma unroll
        for (int kk = 0; kk < 16; ++kk) {
            float a[8], w[8];
#pragma unroll
            for (int i = 0; i < 8; ++i) a[i] = As[kk][ty * 8 + i];
#pragma unroll
            for (int j = 0; j < 8; ++j) w[j] = Ws[kk][tx * 8 + j];
#pragma unroll
            for (int i = 0; i < 8; ++i)
#pragma unroll
                for (int j = 0; j < 8; ++j) acc[i][j] = fmaf(a[i], w[j], acc[i][j]);
        }
        __syncthreads();
    }
#pragma unroll
    for (int i = 0; i < 8; ++i) { const int m = tm + ty * 8 + i; if (m < M && tn + tx * 8 < N) ef(m, tn + tx * 8, acc[i]); }
}
template <class AF, class WF, class EF>
__global__ __launch_bounds__(256) void k_sgemm(int M, int N, int K, AF af, WF wf, EF ef) {
    __shared__ float As[16][132], Ws[16][132];
    sgemm_tile(M, N, K, blockIdx.y * 128, blockIdx.x * 128, af, wf, ef, As, Ws);
}
struct ABf { const bf16* A; int lda, pad; __device__ float operator()(int m, int k) const { return bf2f(A[(size_t)m * lda + k]); } };
struct ABfG { const bf16* A; const float* g; int lda, pad; __device__ float operator()(int m, int k) const { return bf2f(A[(size_t)m * lda + k]) * g[k]; } };
struct WF32 { const float* W; int ldw, pad; __device__ float operator()(int k, int n) const { return W[(size_t)k * ldw + n]; } };
struct EStoreBf { bf16* C; int ldc, pad; __device__ void operator()(int m, int n0, const float (&a)[8]) const {
    *(uint4*)(C + (size_t)m * ldc + n0) = make_uint4(pk2(a[0], a[1]), pk2(a[2], a[3]), pk2(a[4], a[5]), pk2(a[6], a[7])); } };
struct EQup { bf16* QM; const float* rq; __device__ void operator()(int m, int n0, const float (&a)[8]) const { const float r = rq[m];
    *(uint4*)(QM + (size_t)m * 768 + n0) = make_uint4(pk2(a[0] * r, a[1] * r), pk2(a[2] * r, a[3] * r), pk2(a[4] * r, a[5] * r), pk2(a[6] * r, a[7] * r)); } };
struct EKVup { bf16 *KM, *VM; const float* rkv; __device__ void operator()(int m, int n0, const float (&a)[8]) const { const float r = rkv[m];
    const int h = n0 >> 7, j = n0 & 127; bf16* dst = j < 64 ? KM + (size_t)m * 768 + h * 96 + j : VM + (size_t)m * 512 + h * 64 + (j - 64);
    *(uint4*)dst = make_uint4(pk2(a[0] * r, a[1] * r), pk2(a[2] * r, a[3] * r), pk2(a[4] * r, a[5] * r), pk2(a[6] * r, a[7] * r)); } };
struct EMerge { float* YF; bf16* YB; const bf16* P; int i, pad; __device__ void operator()(int m, int n0, const float (&a)[8]) const {
    float* y = YF + (size_t)m * D + n0; const bf16* g = P + (size_t)m * LDP + C_GATE + i * D + n0; float o[8];
#pragma unroll
    for (int j = 0; j < 8; ++j) { o[j] = sigmoidf_(bf2f(g[j])) * a[j]; if (i > 0) o[j] += y[j]; }
    if (i < 2) {
#pragma unroll
        for (int j = 0; j < 8; ++j) y[j] = o[j]; }
    else *(uint4*)(YB + (size_t)m * D + n0) = make_uint4(pk2(o[0], o[1]), pk2(o[2], o[3]), pk2(o[4], o[5]), pk2(o[6], o[7])); } };
struct EWout { Ptrs p; int l, pad; __device__ void operator()(int m, int n0, const float (&a)[8]) const {
    const float* xs = xrow_src(p, l, m) + n0; const float* g1 = (const float*)(p.ws + WS_MOD) + ((size_t)l * 17 + mod_row(m)) * 6 * D + 2 * D + n0;
    float* xb = (float*)(p.ws + WS_XB) + (size_t)m * D + n0;
#pragma unroll
    for (int j = 0; j < 8; ++j) xb[j] = xs[j] + g1[j] * a[j]; } };

__device__ __forceinline__ bool moe_tile(const unsigned* cnt, int ti, int gran, int& e, int& r0, int& ne, int& pstart) {
    int ps = 0;
    for (int x = 0; x < NEXP; ++x) { const int c = (int)cnt[x], nt = (c + gran - 1) / gran;
        if (ti < nt) { e = x; r0 = ti * gran; ne = c; pstart = ps; return true; }
        ti -= nt; ps += (c + 255) & ~255; }
    return false;
}
struct AGather { const bf16* H; const int* list; __device__ float operator()(int m, int k) const { return bf2f(H[(size_t)list[m] * D + k]); } };
struct EGu { bf16* ACT; const float* b; __device__ void operator()(int m, int n0, const float (&a)[8]) const {
    float o[4];
#pragma unroll
    for (int i = 0; i < 4; ++i) { float g = a[2 * i] + b[n0 + 2 * i], u = a[2 * i + 1] + b[n0 + 2 * i + 1]; g = fminf(g, 7.f); u = fminf(fmaxf(u, -7.f), 7.f); o[i] = (u + 1.f) * (g * sigmoidf_(1.702f * g)); }
    *(uint2*)(ACT + (size_t)m * DEXP + (n0 >> 1)) = make_uint2(pk2(o[0], o[1]), pk2(o[2], o[3])); } };
struct EDn { bf16* YM; const float* b; __device__ void operator()(int m, int n0, const float (&a)[8]) const {
    *(uint4*)(YM + (size_t)m * D + n0) = make_uint4(pk2(a[0] + b[n0], a[1] + b[n0 + 1]), pk2(a[2] + b[n0 + 2], a[3] + b[n0 + 3]), pk2(a[4] + b[n0 + 4], a[5] + b[n0 + 5]), pk2(a[6] + b[n0 + 6], a[7] + b[n0 + 7])); } };
__global__ __launch_bounds__(256) void k_moe_gu(Ptrs p, int l) {
    __shared__ float As[16][132], Ws[16][132];
    const unsigned* cnt = (const unsigned*)(p.ws + WS_CTL) + CW_CNT + 32 * l;
    int e, r0, ne, ps; if (!moe_tile(cnt, blockIdx.y, 128, e, r0, ne, ps)) return;
    AGather af{(const bf16*)(p.ws + WS_H), (const int*)(p.ws + WS_LIST) + (size_t)e * NTOK + r0};
    WF32 wf{p.w_gu + ((size_t)l * NEXP + e) * D * 2 * DEXP, 2 * DEXP};
    EGu ef{(bf16*)(p.ws + WS_ACT) + (size_t)(ps + r0) * DEXP, p.b_gu + ((size_t)l * NEXP + e) * 2 * DEXP};
    sgemm_tile(ne - r0, 2 * DEXP, D, 0, blockIdx.x * 128, af, wf, ef, As, Ws);
}
__global__ __launch_bounds__(256) void k_moe_dn(Ptrs p, int l) {
    __shared__ float As[16][132], Ws[16][132];
    const unsigned* cnt = (const unsigned*)(p.ws + WS_CTL) + CW_CNT + 32 * l;
    int e, r0, ne, ps; if (!moe_tile(cnt, blockIdx.y, 128, e, r0, ne, ps)) return;
    ABf af{(const bf16*)(p.ws + WS_ACT) + (size_t)(ps + r0) * DEXP, DEXP};
    WF32 wf{p.w_dn + ((size_t)l * NEXP + e) * DEXP * D, D};
    EDn ef{(bf16*)(p.ws + WS_YM) + (size_t)(ps + r0) * D, p.b_dn + ((size_t)l * NEXP + e) * D};
    sgemm_tile(ne - r0, D, DEXP, 0, blockIdx.x * 128, af, wf, ef, As, Ws);
}

__global__ __launch_bounds__(256) void k_prep(Ptrs p, int l) {
    const int lane = threadIdx.x & 63, row = blockIdx.x * 4 + (threadIdx.x >> 6);
    const bf16* P = (const bf16*)(p.ws + WS_P) + (size_t)row * LDP;
    const bool lat = row < NLAT; const int t = lat ? row % SEQ : (row - NLAT) % CTXL, slen = lat ? SEQ : CTXL;
    { float s = 0.f;
#pragma unroll
      for (int j = 0; j < 6; ++j) { const float v = bf2f(P[C_CQ + lane + 64 * j]); s += v * v; }
      s = wave_sum(s); if (lane == 0) ((float*)(p.ws + WS_RQ))[row] = rsqrtf(s * (1.f / 384.f) + EPS);
      s = 0.f;
#pragma unroll
      for (int j = 0; j < 4; ++j) { const float v = bf2f(P[C_CKV + lane + 64 * j]); s += v * v; }
      s = wave_sum(s); if (lane == 0) ((float*)(p.ws + WS_RKV))[row] = rsqrtf(s * (1.f / 256.f) + EPS); }
    const float prow = (float)(t / 64), pcol = (float)(t % 64);
    { bf16* QS = (bf16*)(p.ws + WS_QS) + (size_t)row * 512; bf16* KS = (bf16*)(p.ws + WS_KS) + (size_t)row * 128;
      for (int it = 0; it < 5; ++it) { const int pi = lane + 64 * it;
        const bool isq = pi < 256; const int hh = isq ? pi / 32 : (pi - 256) / 32, i = pi % 32;
        const bf16* src = P + (isq ? C_SQ : C_SK) + hh * 64; bf16* dst = (isq ? QS : KS) + hh * 64;
        const float x1 = bf2f(src[i]), x2 = bf2f(src[i + 32]);
        float cs = 1.f, sn = 0.f;
        if (lat) { const float inv = powf(10000.f, -(float)(i & 15) / 16.f); const float ang = (i < 16 ? prow : pcol) * inv; cs = cosf(ang); sn = sinf(ang); }
        dst[i] = f2bf(x1 * cs - x2 * sn); dst[i + 32] = f2bf(x2 * cs + x1 * sn); } }
    if (lane < 16) { const int i = lane; const float x1 = bf2f(P[C_KR + i]), x2 = bf2f(P[C_KR + i + 16]);
        float cs = 1.f, sn = 0.f;
        if (lat) { const float inv = powf(10000.f, -(float)(i & 7) / 8.f); const float ang = (i < 8 ? prow : pcol) * inv; cs = cosf(ang); sn = sinf(ang); }
        const bf16 o1 = f2bf(x1 * cs - x2 * sn), o2 = f2bf(x2 * cs + x1 * sn);
        bf16* KM = (bf16*)(p.ws + WS_KM) + (size_t)row * 768;
#pragma unroll
        for (int h = 0; h < 8; ++h) { KM[h * 96 + 64 + i] = o1; KM[h * 96 + 80 + i] = o2; } }
    { const float* cw = p.conv_w + (size_t)l * 5 * 1536;
      bf16* DQ = (bf16*)(p.ws + WS_DQ) + (size_t)row * 512; bf16* DK = (bf16*)(p.ws + WS_DK) + (size_t)row * 512; bf16* DV = (bf16*)(p.ws + WS_DV) + (size_t)row * 512;
      for (int j = 0; j < 24; ++j) { const int c = lane + 64 * j; float y = 0.f;
#pragma unroll
        for (int tap = 0; tap < 5; ++tap) { const int tt = t + tap - 2; if (tt >= 0 && tt < slen) y += bf2f(P[(ptrdiff_t)(tap - 2) * LDP + C_DQKV + c]) * cw[tap * 1536 + c]; }
        y = siluf_(y);
        if (j < 16) { const float ss = wave_sum(y * y); y *= rsqrtf(ss + EPS); if (j < 8) y *= 0.125f; }
        if (j < 8) DQ[c] = f2bf(y); else if (j < 16) DK[c - 512] = f2bf(y); else DV[c - 1024] = f2bf(y); } }
    if (lane < 16) { const float braw = bf2f(P[C_DBETA + lane]), araw = bf2f(P[C_DA + lane]);
        ((float*)(p.ws + WS_DB))[(size_t)row * 16 + lane] = sigmoidf_(braw);
        ((float*)(p.ws + WS_DG))[(size_t)row * 16 + lane] = -__expf(p.a_log[l * 16 + lane]) * softplusf_(araw + p.dt_bias[l * 16 + lane]); }
}
__global__ void k_rope_q(Ptrs p) {
    const int idx = blockIdx.x * 256 + threadIdx.x; const int i = idx & 15, h = (idx >> 4) & 7, row = idx >> 7;
    if (row >= NLAT) return;
    const int t = row % SEQ; bf16* q = (bf16*)(p.ws + WS_QM) + (size_t)row * 768 + h * 96 + 64;
    const float inv = powf(10000.f, -(float)(i & 7) / 8.f); const float ang = (i < 8 ? (float)(t / 64) : (float)(t % 64)) * inv; const float cs = cosf(ang), sn = sinf(ang);
    const float x1 = bf2f(q[i]), x2 = bf2f(q[i + 16]);
    q[i] = f2bf(x1 * cs - x2 * sn); q[i + 16] = f2bf(x2 * cs + x1 * sn);
}

template <int DK, int MODE>
__global__ __launch_bounds__(64) void k_attn(Ptrs p, int l, int ctxq) {
    constexpr int DV = 64, KT = 32;
    __shared__ float Ks[KT][DK], Vs[KT][DV];
    const int qb = blockIdx.x, h = blockIdx.y, b = blockIdx.z, tid = threadIdx.x;
    const int t = qb * 64 + tid, qrow = ctxq ? NLAT + b * CTXL + t : b * SEQ + t;
    const bf16* Qp = MODE == 0 ? (const bf16*)(p.ws + WS_QM) + (size_t)qrow * 768 + h * 96 : (const bf16*)(p.ws + WS_QS) + (size_t)qrow * 512 + h * 64;
    const float scale = MODE == 0 ? 0.10206207261596575f : 0.125f;
    float q[DK], o[DV];
#pragma unroll
    for (int i = 0; i < DK; ++i) q[i] = bf2f(Qp[i]) * scale;
#pragma unroll
    for (int i = 0; i < DV; ++i) o[i] = 0.f;
    float m = -1e30f, lsum = 0.f;
    if (MODE == 1) { m = p.sink[l * 8 + h]; lsum = 1.f; }
    if (MODE == 0 && !ctxq) {
#pragma unroll
        for (int i = 0; i < 16; ++i) { const float inv = powf(10000.f, -(float)(i & 7) / 8.f); const float ang = (i < 8 ? (float)(t / 64) : (float)(t % 64)) * inv; const float cs = cosf(ang), sn = sinf(ang);
            const float x1 = q[DK - 32 + i], x2 = q[DK - 16 + i]; q[DK - 32 + i] = x1 * cs - x2 * sn; q[DK - 16 + i] = x2 * cs + x1 * sn; } }
    for (int seg = 0; seg < (ctxq ? 1 : 2); ++seg) {
        int k0 = 0, k1 = CTXL; if (seg == 1) { k0 = 0; k1 = SEQ; if (MODE == 1) { k0 = max(0, qb * 64 - 128); k1 = min(SEQ, qb * 64 + 64 + 128); } }
        const int rbase = seg == 0 ? NLAT + b * CTXL : b * SEQ;
        for (int kt = k0; kt < k1; kt += KT) {
            __syncthreads();
            for (int e = tid; e < KT * DK; e += 64) { const int kk = e / DK, d = e % DK; const int row = rbase + kt + kk;
                Ks[kk][d] = MODE == 0 ? bf2f(((const bf16*)(p.ws + WS_KM))[(size_t)row * 768 + h * 96 + d]) : bf2f(((const bf16*)(p.ws + WS_KS))[(size_t)row * 128 + (h >> 2) * 64 + d]); }
            for (int e = tid; e < KT * DV; e += 64) { const int kk = e / DV, d = e % DV; const int row = rbase + kt + kk;
                Vs[kk][d] = MODE == 0 ? bf2f(((const bf16*)(p.ws + WS_VM))[(size_t)row * 512 + h * 64 + d]) : bf2f(((const bf16*)(p.ws + WS_P))[(size_t)row * LDP + C_SV + (h >> 2) * 64 + d]); }
            __syncthreads();
            for (int kk = 0; kk < KT; ++kk) {
                if (MODE == 1 && seg == 1) { const int dlt = kt + kk - t; if (dlt > 128 || dlt < -128) continue; }
                float s = 0.f;
#pragma unroll
                for (int i = 0; i < DK; ++i) s = fmaf(q[i], Ks[kk][i], s);
                const float mn = fmaxf(m, s), c = __expf(m - mn), pe = __expf(s - mn);
                lsum = lsum * c + pe; m = mn;
#pragma unroll
                for (int i = 0; i < DV; ++i) o[i] = fmaf(pe, Vs[kk][i], o[i] * c);
            }
        }
    }
    const float inv = 1.f / lsum;
    bf16* O = (bf16*)(p.ws + WS_BR) + (size_t)(MODE == 0 ? 0 : 1) * NTOK * 512 + (size_t)qrow * 512 + h * 64;
#pragma unroll
    for (int i = 0; i < DV; i += 2) *(unsigned*)(O + i) = pk2(o[i] * inv, o[i + 1] * inv);
}

__global__ __launch_bounds__(64) void k_dn_scan(Ptrs p) {
    constexpr int CH = 32;
    __shared__ float qs[CH][64], ks[CH][64], vs[CH][64], gs[CH], bs[CH]; __shared__ int rs[CH];
    const int b = blockIdx.x, h = blockIdx.y, dir = blockIdx.z, v = threadIdx.x;
    float S[64];
#pragma unroll
    for (int i = 0; i < 64; ++i) S[i] = 0.f;
    float* DO = (float*)(p.ws + WS_DO) + (size_t)dir * NTOK * 512;
    for (int s0 = 0; s0 < CTXL + SEQ; s0 += CH) {
        __syncthreads();
        for (int e = v; e < CH * 64; e += 64) { const int i = e >> 6, d = e & 63; const int s = s0 + i;
            const int row = s < CTXL ? NLAT + b * CTXL + (dir ? CTXL - 1 - s : s) : b * SEQ + (dir ? SEQ - 1 - (s - CTXL) : (s - CTXL));
            qs[i][d] = bf2f(((const bf16*)(p.ws + WS_DQ))[(size_t)row * 512 + h * 64 + d]); ks[i][d] = bf2f(((const bf16*)(p.ws + WS_DK))[(size_t)row * 512 + h * 64 + d]);
            vs[i][d] = bf2f(((const bf16*)(p.ws + WS_DV))[(size_t)row * 512 + h * 64 + d]);
            if (d == 0) { rs[i] = row; gs[i] = ((const float*)(p.ws + WS_DG))[(size_t)row * 16 + dir * 8 + h]; bs[i] = ((const float*)(p.ws + WS_DB))[(size_t)row * 16 + dir * 8 + h]; } }
        __syncthreads();
        for (int i = 0; i < CH; ++i) {
            float kS = 0.f;
#pragma unroll
            for (int k = 0; k < 64; ++k) kS = fmaf(ks[i][k], S[k], kS);
            const float a = __expf(gs[i]), dl = bs[i] * (vs[i][v] - a * kS);
            float o = 0.f;
#pragma unroll
            for (int k = 0; k < 64; ++k) { S[k] = fmaf(ks[i][k], dl, a * S[k]); o = fmaf(qs[i][k], S[k], o); }
            DO[(size_t)rs[i] * 512 + h * 64 + v] = o;
        }
    }
}
__global__ __launch_bounds__(256) void k_dn_post(Ptrs p, int l, int nrows) {
    const int lane = threadIdx.x & 63, row = blockIdx.x * 4 + (threadIdx.x >> 6);
    if (row >= nrows) return;
    const float* o0 = (const float*)(p.ws + WS_DO) + (size_t)row * 512 + lane * 8; const float* o1 = o0 + (size_t)NTOK * 512;
    float v[8], s = 0.f;
#pragma unroll
    for (int i = 0; i < 8; ++i) { v[i] = o0[i] + o1[i]; s += v[i] * v[i]; }
    s += __shfl_xor(s, 1); s += __shfl_xor(s, 2); s += __shfl_xor(s, 4);
    const float r = rsqrtf(s * (1.f / 64.f) + EPS);
    const bf16* z = (const bf16*)(p.ws + WS_P) + (size_t)row * LDP + C_DZ + lane * 8; const float* ng = p.dn_norm_g + l * 64 + (lane & 7) * 8;
    float o[8];
#pragma unroll
    for (int i = 0; i < 8; ++i) o[i] = v[i] * r * ng[i] * siluf_(bf2f(z[i]));
    *(uint4*)((bf16*)(p.ws + WS_BR) + (size_t)2 * NTOK * 512 + (size_t)row * 512 + lane * 8) = make_uint4(pk2(o[0], o[1]), pk2(o[2], o[3]), pk2(o[4], o[5]), pk2(o[6], o[7]));
}

constexpr int R2_ROWS = 64;
__global__ __launch_bounds__(256) void k_norm2_router(Ptrs p, int l, int nrows) {
    __shared__ float hrow[4][D]; __shared__ unsigned hist[NEXP], base[NEXP]; __shared__ int se[R2_ROWS * 4], sp[R2_ROWS * 4];
    const int lane = threadIdx.x & 63, w = threadIdx.x >> 6;
    if (threadIdx.x < NEXP) hist[threadIdx.x] = 0u;
    __syncthreads();
    const float* rw = p.router_w + (size_t)l * D * NEXP; const float* rb = p.router_b + l * NEXP;
    unsigned* cnt = (unsigned*)(p.ws + WS_CTL) + CW_CNT + 32 * l;
    int* TE = (int*)(p.ws + WS_TOPE); int* TP = (int*)(p.ws + WS_TOPP); float* TG = (float*)(p.ws + WS_TOPG);
    for (int rr = w; rr < R2_ROWS; rr += 4) { const int row = blockIdx.x * R2_ROWS + rr; if (row >= nrows) break;
        const float* src = (const float*)(p.ws + WS_XB) + (size_t)row * D;
        float v[16]; float s = 0.f;
#pragma unroll
        for (int j = 0; j < 4; ++j) { const float4 t4 = *(const float4*)(src + j * 256 + lane * 4); v[4 * j] = t4.x; v[4 * j + 1] = t4.y; v[4 * j + 2] = t4.z; v[4 * j + 3] = t4.w; }
#pragma unroll
        for (int i = 0; i < 16; ++i) s += v[i] * v[i];
        const float r = rsqrtf(wave_sum(s) * (1.f / D) + EPS);
        const float* ng = p.norm2_g + (size_t)l * D; const float* modv = (const float*)(p.ws + WS_MOD) + ((size_t)l * 17 + mod_row(row)) * 6 * D + 3 * D;
        bf16* h = (bf16*)(p.ws + WS_H) + (size_t)row * D;
#pragma unroll
        for (int j = 0; j < 4; ++j) { float o[4];
#pragma unroll
            for (int i = 0; i < 4; ++i) { const int c = j * 256 + lane * 4 + i; o[i] = v[4 * j + i] * r * ng[c] * (1.f + modv[D + c]) + modv[c]; hrow[w][c] = o[i]; }
            *(uint2*)(h + j * 256 + lane * 4) = make_uint2(pk2(o[0], o[1]), pk2(o[2], o[3])); }
        asm volatile("s_waitcnt lgkmcnt(0)" ::: "memory");
        const int e = lane & 31, kh = lane >> 5; float acc = 0.f;
        for (int k = kh * 512; k < kh * 512 + 512; ++k) acc = fmaf(hrow[w][k], rw[(size_t)k * NEXP + e], acc);
        acc += __shfl_xor(acc, 32); acc += rb[e];
        float cur = acc, myv = 0.f, mx = 0.f, den = 0.f; int mye = 0;
#pragma unroll
        for (int k = 0; k < 4; ++k) { float bv = cur; int be = e;
#pragma unroll
            for (int o = 1; o < 32; o <<= 1) { const float ov = __shfl_xor(bv, o); const int oe = __shfl_xor(be, o); if (ov > bv || (ov == bv && oe < be)) { bv = ov; be = oe; } }
            if (k == 0) mx = bv;
            const float ex = __expf(bv - mx); den += ex;
            if (lane == k) { myv = ex; mye = be; }
            if (e == be) cur = -3.0e38f; }
        if (lane < 4) { const int k = lane;
            TE[(size_t)row * 4 + k] = mye; TG[(size_t)row * 4 + k] = myv / den; se[rr * 4 + k] = mye; sp[rr * 4 + k] = (int)atomicAdd(&hist[mye], 1u); }
    }
    __syncthreads();
    if (threadIdx.x < NEXP) base[threadIdx.x] = atomicAdd(&cnt[threadIdx.x], hist[threadIdx.x]);
    __syncthreads();
    int* LIST = (int*)(p.ws + WS_LIST);
    for (int i = threadIdx.x; i < R2_ROWS * 4; i += 256) { const int row = blockIdx.x * R2_ROWS + (i >> 2); if (row >= nrows) break;
        const int e = se[i]; const int pos = sp[i] + (int)base[e];
        TP[(size_t)row * 4 + (i & 3)] = pos; LIST[(size_t)e * NTOK + pos] = row; }
}

template <class AF, class WF, class EF>
static void run_sgemm(hipStream_t st, int M, int N, int K, const AF& af, const WF& wf, const EF& ef) {
    hipLaunchKernelGGL((k_sgemm<AF, WF, EF>), dim3((N + 127) / 128, (M + 127) / 128), dim3(256), 0, st, M, N, K, af, wf, ef);
}
static Ptrs make_ptrs(void* const* d_in, void* d_out, void* d_ws) {
    Ptrs p{};
    const float** f = (const float**)&p;
    for (int i = 0; i < 27; ++i) f[i] = (const float*)d_in[i];
    p.out = (float*)d_out; p.ws = (unsigned char*)d_ws;
    return p;
}
static void simple_layer_front(const Ptrs& p, hipStream_t st, int l) {
    unsigned char* ws = p.ws;
    hipLaunchKernelGGL(k_norm1, dim3(NTOK / 4), dim3(256), 0, st, p, l, NTOK, 0);
    run_sgemm(st, NTOK, DIN, D, ABf{(const bf16*)(ws + WS_H), D, 0}, WF32{p.w_in + (size_t)l * D * DIN, DIN, 0}, EStoreBf{(bf16*)(ws + WS_P), LDP, 0});
    hipLaunchKernelGGL(k_prep, dim3(NTOK / 4), dim3(256), 0, st, p, l);
    run_sgemm(st, NTOK, 768, 384, ABfG{(const bf16*)(ws + WS_P) + C_CQ, p.q_norm_g + l * 384, LDP, 0}, WF32{p.w_q_up + (size_t)l * 384 * 768, 768, 0}, EQup{(bf16*)(ws + WS_QM), (const float*)(ws + WS_RQ)});
    run_sgemm(st, NTOK, 1024, 256, ABfG{(const bf16*)(ws + WS_P) + C_CKV, p.kv_norm_g + l * 256, LDP, 0}, WF32{p.w_kv_up + (size_t)l * 256 * 1024, 1024, 0},
              EKVup{(bf16*)(ws + WS_KM), (bf16*)(ws + WS_VM), (const float*)(ws + WS_RKV)});
}
static void simple_mixers(const Ptrs& p, hipStream_t st, int l) {
    hipLaunchKernelGGL((k_attn<96, 0>), dim3(SEQ / 64, 8, NB), dim3(64), 0, st, p, l, 0);
    if (l == 0) hipLaunchKernelGGL((k_attn<96, 0>), dim3(CTXL / 64, 8, NB), dim3(64), 0, st, p, l, 1);
    hipLaunchKernelGGL((k_attn<64, 1>), dim3(SEQ / 64, 8, NB), dim3(64), 0, st, p, l, 0);
    if (l == 0) hipLaunchKernelGGL((k_attn<64, 1>), dim3(CTXL / 64, 8, NB), dim3(64), 0, st, p, l, 1);
    hipLaunchKernelGGL(k_dn_scan, dim3(NB, 8, 2), dim3(64), 0, st, p);
    hipLaunchKernelGGL(k_dn_post, dim3((l == 0 ? NTOK : NLAT) / 4), dim3(256), 0, st, p, l, l == 0 ? NTOK : NLAT);
}
static void simple_merge(const Ptrs& p, hipStream_t st, int l) {
    unsigned char* ws = p.ws; const int nq = l == 0 ? NTOK : NLAT;
    for (int i = 0; i < 3; ++i)
        run_sgemm(st, nq, D, 512, ABf{(const bf16*)(ws + WS_BR) + (size_t)i * NTOK * 512, 512, 0}, WF32{p.w_branch + ((size_t)l * 3 + i) * 512 * D, D, 0},
                  EMerge{(float*)(ws + WS_YF), (bf16*)(ws + WS_YB), (const bf16*)(ws + WS_P), i, 0});
    run_sgemm(st, nq, D, D, ABf{(const bf16*)(ws + WS_YB), D, 0}, WF32{p.w_out + (size_t)l * D * D, D, 0}, EWout{p, l, 0});
}
static void simple_moe(const Ptrs& p, hipStream_t st, int l) {
    const int nq = l == 0 ? NTOK : NLAT;
    hipLaunchKernelGGL(k_norm2_router, dim3(nq / R2_ROWS), dim3(256), 0, st, p, l, nq);
    hipLaunchKernelGGL(k_moe_gu, dim3(2 * DEXP / 128, NTOK * 4 / 128 + NEXP), dim3(256), 0, st, p, l);
    hipLaunchKernelGGL(k_moe_dn, dim3(D / 128, NTOK * 4 / 128 + NEXP), dim3(256), 0, st, p, l);
}

#define LAS __attribute__((address_space(3)))
#define GAS __attribute__((address_space(1)))
typedef short bf16x8 __attribute__((ext_vector_type(8)));
typedef float f32x4 __attribute__((ext_vector_type(4)));
typedef float f32x2 __attribute__((ext_vector_type(2)));
typedef unsigned u32x4 __attribute__((ext_vector_type(4)));
typedef unsigned u32x2 __attribute__((ext_vector_type(2)));
__device__ __forceinline__ int lane_id() { int l; asm volatile("v_mbcnt_lo_u32_b32 %0, -1, 0\n\tv_mbcnt_hi_u32_b32 %0, -1, %0" : "=v"(l)); return l; }
constexpr int NWAVES = 8, NTHR = 512;
constexpr int BM = 256, BK = 64, HALF = 128, HTB = HALF * BK * 2, STAGE_BYTES = 8 * HTB;
constexpr int LDS_MISC_OFF = STAGE_BYTES;
constexpr int LDS_TAB_OFF = STAGE_BYTES + 1024;
constexpr int LDS_BYTES = 147456;
constexpr size_t WS_ROPES = 5 * MiB + 256 * 1024, WS_ROPEM = 8 * MiB + 512 * 1024;
constexpr size_t WS_Z = WS_PREP;
constexpr size_t WS_WOUT3 = WS_END;
constexpr size_t WS_END2 = WS_END + 12 * MiB;

#define XB_TMO      128
#define XB_XCNT(j)  (256  + 64 * (j))
#define XB_XSUB(j)  (1280 + 64 * (j))
#define XB_XGEN(j)  (2304 + 64 * (j))
#define XB_TOP      3328
#define XB_TOPGEN   3392
#define XCD_BAR_WORDS 3456
#define XB_SPIN_CAP (1u << 18)
__device__ __forceinline__ unsigned xb_ld(unsigned* p)              { return __hip_atomic_load(p, __ATOMIC_RELAXED, __HIP_MEMORY_SCOPE_AGENT); }
__device__ __forceinline__ unsigned xb_add(unsigned* p, unsigned v) { return __hip_atomic_fetch_add(p, v, __ATOMIC_RELAXED, __HIP_MEMORY_SCOPE_AGENT); }
__device__ __forceinline__ unsigned xb_xcc_id() { return (unsigned)__builtin_amdgcn_s_getreg((3 << 11) | 20) & 0xFu; }
#define XB_SPIN(cond, bar) do { unsigned _sp = 0; while (cond) { __builtin_amdgcn_s_sleep(1); \
    if ((++_sp & 255u) == 0u) { if (xb_ld(&(bar)[XB_TMO])) break; if (_sp > XB_SPIN_CAP) { atomicAdd(&(bar)[XB_TMO], 1u); break; } } } } while (0)
struct XcdBarrier { unsigned* bar; unsigned x; volatile LAS unsigned* st; };
__device__ __forceinline__ XcdBarrier xcd_barrier_post(unsigned* bar, volatile LAS unsigned* st) {
    XcdBarrier b; b.bar = bar; b.x = xb_xcc_id(); b.st = st;
    if (threadIdx.x == 0) (void)xb_add(&bar[XB_XCNT(b.x)], 1u);
    return b;
}
__device__ __forceinline__ void xcd_barrier_complete(unsigned* bar, unsigned x, unsigned& nloc, unsigned& nx) {
    const unsigned G = gridDim.x * gridDim.y * gridDim.z;
    unsigned sum, cnt, mine, sp = 0u;
    for (;;) {
        sum = 0u; cnt = 0u; mine = 0u;
#pragma unroll
        for (unsigned j = 0; j < 16; ++j) { const unsigned c = xb_ld(&bar[XB_XCNT(j)]); sum += c; cnt += (c > 0u) ? 1u : 0u; mine = (j == x) ? c : mine; }
        if (sum == G) break;
        __builtin_amdgcn_s_sleep(1);
        if ((++sp & 255u) == 0u) { if (xb_ld(&bar[XB_TMO])) break; if (sp > XB_SPIN_CAP) { atomicAdd(&bar[XB_TMO], 1u); break; } }
    }
    nloc = mine > 0u ? mine : 1u; nx = cnt > 0u ? cnt : 1u;
}
__device__ __noinline__ void xcd_barrier_impl(unsigned* bar, unsigned bx, unsigned st_off, int wave) {
    volatile LAS unsigned* st = (volatile LAS unsigned*)(unsigned long long)st_off;
    asm volatile("s_waitcnt vmcnt(0)" ::: "memory");
    __syncthreads();
    if (wave == 0 && lane_id() == 0) {
        __builtin_amdgcn_s_waitcnt(0);
        unsigned nloc = st[0], nx = st[1];
        if (nloc == 0u) { xcd_barrier_complete(bar, bx, nloc, nx); st[0] = nloc; st[1] = nx; }
        const unsigned old = xb_add(&bar[XB_XSUB(bx)], 1u);
        const unsigned gen = old / nloc;
        if (old + 1u == (gen + 1u) * nloc) {
            __builtin_amdgcn_fence(__ATOMIC_RELEASE, "agent");
            asm volatile("s_waitcnt vmcnt(0)" ::: "memory");
            const unsigned og = xb_add(&bar[XB_TOP], 1u);
            const unsigned tg = og / nx;
            if (og + 1u == (tg + 1u) * nx) xb_add(&bar[XB_TOPGEN], 1u);
            else XB_SPIN(xb_ld(&bar[XB_TOPGEN]) == tg, bar);
            __builtin_amdgcn_fence(__ATOMIC_ACQUIRE, "agent");
            xb_add(&bar[XB_XGEN(bx)], 1u);
            asm volatile("s_waitcnt vmcnt(0)" ::: "memory");
        } else {
            XB_SPIN(xb_ld(&bar[XB_XGEN(bx)]) == gen, bar);
            __builtin_amdgcn_fence(__ATOMIC_ACQUIRE, "agent");
            asm volatile("s_waitcnt vmcnt(0)" ::: "memory");
        }
    }
    __syncthreads();
}
__device__ __forceinline__ void xcd_barrier(const XcdBarrier& b, int wave) { xcd_barrier_impl(b.bar, b.x, (unsigned)(unsigned long long)b.st, wave); }

#ifndef DENSE_WGM
#define DENSE_WGM 8
#endif
#ifndef GEMM_SP2
#define GEMM_SP2 1
#endif
#ifndef GEMM_ALIGN
#define GEMM_ALIGN 1
#endif
__device__ __forceinline__ int lds_byte(int r, int c) { const int st = (r >> 4) * 2 + (c >> 5), rr = r & 15, cc = c & 31, ob = rr * 64 + cc * 2; return st * 1024 + (ob ^ (((ob >> 9) & 1) << 5)); }
__device__ __forceinline__ void stage_rc(int b, int& R, int& C) { const int st = b / 1024, sb = b % 1024, swz = sb ^ (((sb >> 9) & 1) << 5); R = (st >> 1) * 16 + swz / 64; C = (st & 1) * 32 + (swz % 64) / 2; }
__device__ __forceinline__ int perm32(int rho) { const int n = rho >> 4, i = rho & 15; return 8 * (i >> 2) + 4 * n + (i & 3); }
typedef __bf16 bf16x2v __attribute__((ext_vector_type(2)));
__device__ __forceinline__ unsigned cvt_pk_bf16(float lo, float hi) { return __builtin_bit_cast(unsigned, __builtin_convertvector((f32x2){lo, hi}, bf16x2v)); }

struct GUnit { const char* A0; const char* A1; const char* B; const int* rows; int nvalid, rowbase, colbase, e, pm; };

template <class Epi, class Sched, bool GATHER>
__device__ __forceinline__ void gemm_phase(LAS unsigned char* lds, const int K, const int lda  , const Sched& S, const Epi& E, const int wid) {
    const int lane = lane_id(), tid = wid * 64 + lane;
    const int wr = wid >> 2, wc = wid & 3, fr = lane & 15, fq = lane >> 4;
    const int nt = K / BK;
    unsigned voffB[2], vA[2][2], vAn[2][2];
#pragma unroll
    for (int i = 0; i < 2; ++i) { int sR, sC; stage_rc(tid * 16 + i * 8192, sR, sC); const int Rb = Epi::PERM ? ((sR & ~31) + perm32(sR & 31)) : sR; voffB[i] = (unsigned)(Rb * K + sC) * 2u; }
    const size_t kstep = (size_t)(BK * 2), hstepB = (size_t)HALF * K * 2;
    const unsigned ldsw = (unsigned)wid * 1024u;
    const int aoff = lds_byte(wr * 64 + fr, fq * 8), boff = lds_byte(wc * 32 + fr, fq * 8);
#define G_SA(b, h) (((b) * 2 + (h)) * HTB)
#define G_SB(b, h) ((4 + (b) * 2 + (h)) * HTB)
#define G_OPQ(x) ({ unsigned _o = (x); asm volatile("" : "+v"(_o)); _o; })
#define G_STAGE_B(bufoff, gbase) do { _Pragma("unroll") for (int _i = 0; _i < 2; ++_i) \
        __builtin_amdgcn_global_load_lds((const unsigned*)((const char*)(gbase) + G_OPQ(voffB[_i])), (LAS unsigned*)(lds + (bufoff) + ldsw + _i * 8192), 16, 0, 0); } while (0)
#define G_STAGE_A(bufoff, gbase, o0, o1) do { \
        __builtin_amdgcn_global_load_lds((const unsigned*)((const char*)(gbase) + G_OPQ(o0)), (LAS unsigned*)(lds + (bufoff) + ldsw), 16, 0, 0); \
        __builtin_amdgcn_global_load_lds((const unsigned*)((const char*)(gbase) + G_OPQ(o1)), (LAS unsigned*)(lds + (bufoff) + ldsw + 8192), 16, 0, 0); } while (0)
#define G_LDA(dst, b, h) do { _Pragma("unroll") for (int m = 0; m < 4; ++m) _Pragma("unroll") for (int k = 0; k < 2; ++k) dst[m][k] = *(const LAS bf16x8*)(lds + G_SA(b, h) + aoff + m * 2048 + k * 1024); } while (0)
#define G_LDB(dst, b, h) do { _Pragma("unroll") for (int n = 0; n < 2; ++n) _Pragma("unroll") for (int k = 0; k < 2; ++k) dst[n][k] = *(const LAS bf16x8*)(lds + G_SB(b, h) + boff + n * 2048 + k * 1024); } while (0)
#define G_MMA(ai, bj, At, Bt) do { __builtin_amdgcn_s_setprio(1); _Pragma("unroll") for (int m = 0; m < 4; ++m) _Pragma("unroll") for (int n = 0; n < 2; ++n) _Pragma("unroll") for (int k = 0; k < 2; ++k) \
        acc[ai][bj][m][n] = __builtin_amdgcn_mfma_f32_16x16x32_bf16(Bt[n][k], At[m][k], acc[ai][bj][m][n], 0, 0, 0); __builtin_amdgcn_s_setprio(0); } while (0)
#define G_WAIT_V(n) asm volatile("s_waitcnt vmcnt(" #n ")" ::: "memory")
#define G_WAIT_L(n) asm volatile("s_waitcnt lgkmcnt(" #n ")" ::: "memory")
#define G_BAR __builtin_amdgcn_s_barrier()
#define G_SCHED __builtin_amdgcn_sched_barrier(0)
#define G_VOFF(u, vv) do { int _ld[2][2]; if (GATHER) { _Pragma("unroll") for (int _h = 0; _h < 2; ++_h) _Pragma("unroll") for (int _i = 0; _i < 2; ++_i) { int _R, _C; stage_rc(tid * 16 + _i * 8192, _R, _C); _ld[_h][_i] = (u).rows[_R + 128 * _h]; } } \
        _Pragma("unroll") for (int _h = 0; _h < 2; ++_h) _Pragma("unroll") for (int _i = 0; _i < 2; ++_i) { int _R, _C; stage_rc(tid * 16 + _i * 8192, _R, _C); \
        const int _ri = GATHER ? ((_R + 128 * _h) < (u).nvalid ? _ld[_h][_i] : 0) : _R; vv[_h][_i] = (unsigned)_ri * (unsigned)lda + (unsigned)_C * 2u; } } while (0)
    GUnit cur, nxt; int ui = 0;
    if (!S.next(0, cur)) return;
    G_VOFF(cur, vA);
    f32x4 acc[2][2][4][2];
#pragma unroll
    for (int a = 0; a < 2; ++a)
#pragma unroll
        for (int b = 0; b < 2; ++b)
#pragma unroll
            for (int m = 0; m < 4; ++m)
#pragma unroll
                for (int n = 0; n < 2; ++n) acc[a][b][m][n] = (f32x4){0.f, 0.f, 0.f, 0.f};
    bf16x8 At[4][2], B0[2][2], B1[2][2];
    const char* cA0 = cur.A0; const char* cA1 = cur.A1; const char* cB = cur.B;
    typename Epi::Pre pre; E.prefetch(cur, wc, fq, pre);
    if (GEMM_SP2) {
        G_STAGE_B(G_SB(0, 0), cB); G_STAGE_B(G_SB(0, 1), cB + hstepB); G_STAGE_A(G_SA(0, 0), cA0, vA[0][0], vA[0][1]); G_STAGE_A(G_SA(0, 1), cA1, vA[1][0], vA[1][1]);
        if (wr == 1) G_BAR;
        G_WAIT_V(2); G_BAR;
    } else {
        G_STAGE_B(G_SB(0, 0), cB); G_STAGE_A(G_SA(0, 0), cA0, vA[0][0], vA[0][1]); G_STAGE_B(G_SB(0, 1), cB + hstepB); G_STAGE_A(G_SA(0, 1), cA1, vA[1][0], vA[1][1]);
        if (wr == 1) G_BAR;
        G_WAIT_V(4); G_BAR;
    }
    G_STAGE_B(G_SB(1, 0), cB + kstep); G_STAGE_A(G_SA(1, 0), cA0 + kstep, vA[0][0], vA[0][1]); G_STAGE_B(G_SB(1, 1), cB + hstepB + kstep);
    G_WAIT_V(6); G_BAR;
    for (;;) {
        const bool has_next = S.next(ui + 1, nxt);
        if (has_next) { G_VOFF(nxt, vAn); }
        else {
#pragma unroll
            for (int h = 0; h < 2; ++h)
#pragma unroll
                for (int i = 0; i < 2; ++i) vAn[h][i] = vA[h][i]; }
        const char* nA0 = has_next ? nxt.A0 : cA0; const char* nA1 = has_next ? nxt.A1 : cA1; const char* nB = has_next ? nxt.B : cB;
#pragma unroll 1
        for (int t = 0; t < nt; t += 2) {
            const bool last = (t == nt - 2);
            const char* a1 = cA1 + (size_t)(t + 1) * kstep;
            const char* a20 = last ? nA0 : cA0 + (size_t)(t + 2) * kstep; const char* a21 = last ? nA1 : cA1 + (size_t)(t + 2) * kstep; const char* b2 = last ? nB : cB + (size_t)(t + 2) * kstep;
            const char* a30 = a20 + kstep; const char* b3 = b2 + kstep;
            const unsigned o00 = last ? vAn[0][0] : vA[0][0], o01 = last ? vAn[0][1] : vA[0][1], o10 = last ? vAn[1][0] : vA[1][0], o11 = last ? vAn[1][1] : vA[1][1];
            if (GEMM_SP2) {
            G_LDB(B0, 0, 0); G_LDB(B1, 0, 1); G_SCHED; G_LDA(At, 0, 0); G_STAGE_A(G_SA(1, 1), a1, vA[1][0], vA[1][1]);
            G_WAIT_V(8); G_WAIT_L(0); G_BAR; G_MMA(0, 0, At, B0); G_MMA(0, 1, At, B1); G_BAR; G_SCHED;
            G_LDA(At, 0, 1); G_STAGE_B(G_SB(0, 0), b2); G_STAGE_B(G_SB(0, 1), b2 + hstepB); G_STAGE_A(G_SA(0, 0), a20, o00, o01);
            G_WAIT_V(8); G_WAIT_L(0); G_BAR; G_MMA(1, 0, At, B0); G_MMA(1, 1, At, B1); G_BAR; G_SCHED;
            G_LDB(B0, 1, 0); G_LDB(B1, 1, 1); G_SCHED; G_LDA(At, 1, 0); G_STAGE_A(G_SA(0, 1), a21, o10, o11);
            G_WAIT_V(8); G_WAIT_L(0); G_BAR; G_MMA(0, 0, At, B0); G_MMA(0, 1, At, B1); G_BAR; G_SCHED;
            G_LDA(At, 1, 1); G_STAGE_B(G_SB(1, 0), b3); G_STAGE_B(G_SB(1, 1), b3 + hstepB); G_STAGE_A(G_SA(1, 0), a30, o00, o01);
            G_WAIT_V(8); G_WAIT_L(0); G_BAR; G_MMA(1, 0, At, B0); G_MMA(1, 1, At, B1); G_BAR; G_SCHED;
            } else {
            G_LDB(B0, 0, 0); G_SCHED; G_LDA(At, 0, 0); G_STAGE_A(G_SA(1, 1), a1, vA[1][0], vA[1][1]);
            G_WAIT_L(8); G_BAR; G_WAIT_L(0); G_MMA(0, 0, At, B0); G_BAR; G_SCHED;
            G_LDB(B1, 0, 1); G_STAGE_B(G_SB(0, 0), b2);
            G_BAR; G_WAIT_L(0); G_MMA(0, 1, At, B1); G_BAR;
            G_LDA(At, 0, 1); G_STAGE_A(G_SA(0, 0), a20, o00, o01);
            G_BAR; G_WAIT_L(0); G_MMA(1, 0, At, B0); G_BAR; G_SCHED;
            G_STAGE_B(G_SB(0, 1), b2 + hstepB);
            G_WAIT_V(6); G_BAR; G_MMA(1, 1, At, B1); G_BAR;
            G_LDB(B0, 1, 0); G_SCHED; G_LDA(At, 1, 0); G_STAGE_A(G_SA(0, 1), a21, o10, o11);
            G_WAIT_L(8); G_BAR; G_WAIT_L(0); G_MMA(0, 0, At, B0); G_BAR; G_SCHED;
            G_LDB(B1, 1, 1); G_STAGE_B(G_SB(1, 0), b3);
            G_BAR; G_WAIT_L(0); G_MMA(0, 1, At, B1); G_BAR;
            G_LDA(At, 1, 1); G_STAGE_A(G_SA(1, 0), a30, o00, o01);
            G_BAR; G_WAIT_L(0); G_MMA(1, 0, At, B0); G_BAR; G_SCHED;
            G_STAGE_B(G_SB(1, 1), b3 + hstepB);
            G_WAIT_V(6); G_BAR; G_MMA(1, 1, At, B1); G_BAR;
            }
        }
        if (GEMM_ALIGN) { if (wr == 0) G_BAR; }
        E(acc, cur, wr, wc, fr, fq, pre);
        if (!has_next) break;
#pragma unroll
        for (int a = 0; a < 2; ++a)
#pragma unroll
            for (int b = 0; b < 2; ++b)
#pragma unroll
                for (int m = 0; m < 4; ++m)
#pragma unroll
                    for (int n = 0; n < 2; ++n) acc[a][b][m][n] = (f32x4){0.f, 0.f, 0.f, 0.f};
        cur = nxt; cA0 = nA0; cA1 = nA1; cB = nB; ++ui;
#pragma unroll
        for (int h = 0; h < 2; ++h)
#pragma unroll
            for (int i = 0; i < 2; ++i) vA[h][i] = vAn[h][i];
        E.prefetch(cur, wc, fq, pre);
        if (GEMM_ALIGN) { if (wr == 1) G_BAR; }
    }
    G_WAIT_V(0);
    if (!GEMM_ALIGN) { if (wr == 0) G_BAR; }
    G_BAR;
#undef G_SA
#undef G_SB
#undef G_STAGE_A
#undef G_STAGE_B
#undef G_LDA
#undef G_LDB
#undef G_MMA
#undef G_WAIT_V
#undef G_WAIT_L
#undef G_BAR
#undef G_SCHED
#undef G_VOFF
#undef G_OPQ
}

struct DenseSched {
    const char* A; const char* B; int nM, nN, nwg, G, c, lda, K; size_t a_split_stride; int csplit;
    int L0 = 0, L1 = 0x7fffffff;
    int xtra = 0;
    __device__ void init(const void* A_, int lda_, const void* B_, int K_, int M, int N, int G_, int c_, int csplit_ = 0, size_t a_split_stride_ = 0) {
        A = (const char*)A_; B = (const char*)B_; lda = lda_; K = K_; nM = M / BM; nN = N / BM; nwg = nM * nN; G = G_; c = c_; csplit = csplit_; a_split_stride = a_split_stride_; }
    __device__ bool next(int i, GUnit& u) const {
        const long L = (long)L0 + (long)i * G + c; if (L >= nwg + xtra || L >= L1) return false;
        int pm, pn;
        if (L >= nwg) { const int j = (int)L - nwg, q = j >> 4; pm = nM + (j & 15); pn = q + 1 + (q >= 2 ? 1 : 0) + (q >= 10 ? 1 : 0); }
        else {
        int wgid = (int)L; { const int q = nwg / 8, r = nwg % 8, xcd = wgid % 8, off = wgid / 8; wgid = (xcd < r ? xcd * (q + 1) : r * (q + 1) + (xcd - r) * q) + off; }
        const int nig = DENSE_WGM * nN, gid = wgid / nig, fm = gid * DENSE_WGM, gsz = (nM - fm) < DENSE_WGM ? (nM - fm) : DENSE_WGM;
        pm = fm + ((wgid % nig) % gsz); pn = (wgid % nig) / gsz; }
        u.A0 = A + (csplit ? (size_t)(pn / csplit) * a_split_stride : 0) + (size_t)pm * BM * lda; u.A1 = u.A0 + (size_t)HALF * lda; u.B = B + (size_t)pn * BM * K * 2; u.rows = nullptr; u.nvalid = BM;
        u.rowbase = pm * BM; u.colbase = pn * BM; u.e = 0; u.pm = pm; return true;
    }
};
struct MergeSched {
    const char* A; const char* B; int nM, G, c; size_t a_stride;
    __device__ bool next(int i, GUnit& u) const {
        const int j = i / 3, br = i - 3 * j, nwg = nM * 4; const long L = (long)j * G + c; if (L >= nwg) return false;
        int wgid = (int)L; { const int q = nwg / 8, r = nwg % 8, xcd = wgid % 8, off = wgid / 8; wgid = (xcd < r ? xcd * (q + 1) : r * (q + 1) + (xcd - r) * q) + off; }
        const int nig = 8 * 4, gid = wgid / nig, fm = gid * 8, gsz = (nM - fm) < 8 ? (nM - fm) : 8;
        const int pm = fm + ((wgid % nig) % gsz), pn = (wgid % nig) / gsz;
        u.A0 = A + (size_t)br * a_stride + (size_t)pm * BM * 1024; u.A1 = u.A0 + (size_t)HALF * 1024; u.B = B + ((size_t)br * 1024 + pn * BM) * 512 * 2; u.rows = nullptr; u.nvalid = BM;
        u.rowbase = pm * BM; u.colbase = pn * BM; u.e = br; u.pm = pm; return true;
    }
};
struct MoeSched {
    const LAS int* pre; const LAS int* ps; const unsigned* cnt; const char* A; const char* B; const int* list; int nct, G, c, K, gather, lda;
    __device__ bool next(int i, GUnit& u) const {
        const int L = i * G + c; if (L >= pre[NEXP]) return false;
        const int ln_ = lane_id();
        const unsigned long long bal_ = __builtin_amdgcn_ballot_w64(L >= pre[ln_ & 31]);
        const int e = __builtin_popcount((unsigned)bal_ & 0xfffffffeu);
        const int loc = L - pre[e], ce = ps[64 + e], pn = loc % nct, tile = loc / nct;
        u.e = e; u.rowbase = ps[e] + tile * BM; u.colbase = pn * BM; u.pm = tile; u.nvalid = ce - tile * BM;
        u.B = B + ((size_t)e * nct + pn) * BM * K * 2;
        if (gather) { u.A0 = A; u.A1 = A; u.rows = list + (size_t)e * NTOK + tile * BM; }
        else { u.A0 = A + (size_t)u.rowbase * lda; u.A1 = u.A0 + (size_t)HALF * lda; u.rows = nullptr; }
        return true;
    }
};
__device__ __forceinline__ void moe_tables(LAS int* pre, LAS int* ps, const unsigned* cnt, int nct, int wave) {
    if (lane_id() == 0 && wave == 0) { int a = 0, s = 0; for (int e = 0; e < NEXP; ++e) { const int c = (int)cnt[e]; pre[e] = a; ps[e] = s; ps[64 + e] = c; a += ((c + 255) >> 8) * nct; s += (c + 255) & ~255; } pre[NEXP] = a; }
    __syncthreads();
}

#define EPI_ARGS const f32x4 (&acc)[2][2][4][2], const GUnit& u, int wr, int wc, int fr, int fq
struct EpiNoPre {};
#define EPI_NOPRE typedef EpiNoPre Pre; __device__ __forceinline__ void prefetch(const GUnit&, int, int, Pre&) const {}
#define EPI_ROWS _Pragma("unroll") for (int ai = 0; ai < 2; ++ai) _Pragma("unroll") for (int m = 0; m < 4; ++m)
__device__ __forceinline__ u32x4 pack8(const f32x4& a, const f32x4& b) { u32x4 w; w.x = cvt_pk_bf16(a[0], a[1]); w.y = cvt_pk_bf16(a[2], a[3]); w.z = cvt_pk_bf16(b[0], b[1]); w.w = cvt_pk_bf16(b[2], b[3]); return w; }
__device__ __forceinline__ void unpack8(const u32x4& w, float (&o)[8]) {
    o[0] = __uint_as_float(w.x << 16); o[1] = __uint_as_float(w.x & 0xffff0000u); o[2] = __uint_as_float(w.y << 16); o[3] = __uint_as_float(w.y & 0xffff0000u);
    o[4] = __uint_as_float(w.z << 16); o[5] = __uint_as_float(w.z & 0xffff0000u); o[6] = __uint_as_float(w.w << 16); o[7] = __uint_as_float(w.w & 0xffff0000u); }

struct EpiWin { EPI_NOPRE static constexpr bool PERM = true; bf16* P;
    __device__ __forceinline__ void operator()(EPI_ARGS, const Pre&) const {
        EPI_ROWS { const int row = u.rowbase + ai * HALF + wr * 64 + m * 16 + fr; bf16* rowp = P + (size_t)row * LDP + u.colbase + wc * 32 + fq * 8;
#pragma unroll
            for (int bj = 0; bj < 2; ++bj) *(u32x4*)(rowp + bj * HALF) = pack8(acc[ai][bj][m][0], acc[ai][bj][m][1]); } } };

struct EpiQup { EPI_NOPRE static constexpr bool PERM = true; bf16* QM; const float* rq;
    __device__ __forceinline__ void operator()(EPI_ARGS, const Pre&) const {
        float r[2][4];
        EPI_ROWS r[ai][m] = rq[u.rowbase + ai * HALF + wr * 64 + m * 16 + fr];
        EPI_ROWS { const int row = u.rowbase + ai * HALF + wr * 64 + m * 16 + fr; bf16* rowp = QM + (size_t)row * 768 + u.colbase + wc * 32 + fq * 8;
#pragma unroll
            for (int bj = 0; bj < 2; ++bj) *(u32x4*)(rowp + bj * HALF) = pack8(acc[ai][bj][m][0] * r[ai][m], acc[ai][bj][m][1] * r[ai][m]); } } };

struct EpiKVup { EPI_NOPRE static constexpr bool PERM = true; bf16 *KM, *VM; const float* rkv;
    __device__ __forceinline__ void operator()(EPI_ARGS, const Pre&) const {
        float r[2][4];
        EPI_ROWS r[ai][m] = rkv[u.rowbase + ai * HALF + wr * 64 + m * 16 + fr];
        EPI_ROWS { const int row = u.rowbase + ai * HALF + wr * 64 + m * 16 + fr;
#pragma unroll
            for (int bj = 0; bj < 2; ++bj) { const int c8 = u.colbase + bj * HALF + wc * 32 + fq * 8, h = c8 >> 7, j = c8 & 127;
                bf16* dst = j < 64 ? KM + (size_t)row * 768 + h * 96 + j : VM + (size_t)row * 512 + h * 64 + (j - 64);
                *(u32x4*)dst = pack8(acc[ai][bj][m][0] * r[ai][m], acc[ai][bj][m][1] * r[ai][m]); } } } };

struct EpiMerge { EPI_NOPRE static constexpr bool PERM = true; bf16* Y; const bf16* P;
    template <bool ACC> __device__ __forceinline__ void body(EPI_ARGS) const {
        const int br = u.e;
#pragma unroll
        for (int ai = 0; ai < 2; ++ai) { u32x4 gt[4][2], pv[4][2];
#pragma unroll
            for (int m = 0; m < 4; ++m)
#pragma unroll
                for (int bj = 0; bj < 2; ++bj) { const int row = u.rowbase + ai * HALF + wr * 64 + m * 16 + fr, c8 = u.colbase + bj * HALF + wc * 32 + fq * 8;
                    gt[m][bj] = *(const u32x4*)(P + (size_t)row * LDP + C_GATE + br * D + c8);
                    if (ACC) pv[m][bj] = *(const u32x4*)(Y + (size_t)row * D + c8); }
#pragma unroll
            for (int m = 0; m < 4; ++m) { const int row = u.rowbase + ai * HALF + wr * 64 + m * 16 + fr;
#pragma unroll
                for (int bj = 0; bj < 2; ++bj) { const int c8 = u.colbase + bj * HALF + wc * 32 + fq * 8; float g[8], y0[8]; unpack8(gt[m][bj], g);
                    if (ACC) unpack8(pv[m][bj], y0);
                    f32x4 v0 = acc[ai][bj][m][0], v1 = acc[ai][bj][m][1];
#pragma unroll
                    for (int j = 0; j < 4; ++j) { v0[j] = v0[j] * sigmoidf_(g[j]) + (ACC ? y0[j] : 0.f); v1[j] = v1[j] * sigmoidf_(g[4 + j]) + (ACC ? y0[4 + j] : 0.f); }
                    *(u32x4*)(Y + (size_t)row * D + c8) = pack8(v0, v1); } } } }
    __device__ __forceinline__ void operator()(EPI_ARGS, const Pre&) const { if (u.e == 0) body<false>(acc, u, wr, wc, fr, fq); else body<true>(acc, u, wr, wc, fr, fq); } };

#ifndef XB_BF16
#define XB_BF16 1
#endif
#if XB_BF16 && !defined(XB_NOEPI)
struct EpiWout { EPI_NOPRE static constexpr bool PERM = true; Ptrs p; int l;
    __device__ __forceinline__ void operator()(EPI_ARGS, const Pre&) const {
        int goff = wc * 32 + fq * 8, xoff = (wr * 64 + fr) * D + wc * 32 + fq * 8;
        asm volatile("" : "+v"(goff), "+v"(xoff));
        const float* g1 = (const float*)(p.ws + WS_MOD) + ((size_t)l * 17 + mod_row(u.rowbase)) * 6 * D + 2 * D + u.colbase;
        bf16* xt = (bf16*)(p.ws + WS_XB) + (size_t)u.rowbase * D + u.colbase;
        f32x4 gv[2][2];
#pragma unroll
        for (int bj = 0; bj < 2; ++bj)
#pragma unroll
            for (int n = 0; n < 2; ++n) gv[bj][n] = *(const f32x4*)(g1 + goff + bj * HALF + n * 4);
#pragma unroll
        for (int ai = 0; ai < 2; ++ai) { u32x4 xv[4][2];
#pragma unroll
            for (int m = 0; m < 4; ++m)
#pragma unroll
                for (int bj = 0; bj < 2; ++bj) xv[m][bj] = *(const u32x4*)(xt + xoff + (ai * HALF + m * 16) * D + bj * HALF);
#pragma unroll
            for (int m = 0; m < 4; ++m)
#pragma unroll
                for (int bj = 0; bj < 2; ++bj) { float xo[8]; unpack8(xv[m][bj], xo);
                    const f32x4 o0 = (f32x4){xo[0], xo[1], xo[2], xo[3]} + gv[bj][0] * acc[ai][bj][m][0], o1 = (f32x4){xo[4], xo[5], xo[6], xo[7]} + gv[bj][1] * acc[ai][bj][m][1];
                    *(u32x4*)(xt + xoff + (ai * HALF + m * 16) * D + bj * HALF) = pack8(o0, o1); } } } };
#else
struct EpiWout { EPI_NOPRE static constexpr bool PERM = false; Ptrs p; int l;
    __device__ __forceinline__ void operator()(EPI_ARGS, const Pre&) const {
        const float* g1 = (const float*)(p.ws + WS_MOD) + ((size_t)l * 17 + mod_row(u.rowbase)) * 6 * D + 2 * D;
        const float* xs0 = (l == 0 ? (u.rowbase < NLAT ? p.x + (size_t)u.rowbase * D : p.ctx + (size_t)(u.rowbase - NLAT) * D) : (const float*)(p.ws + WS_XB) + (size_t)u.rowbase * D);
        f32x4 gv[2][2];
#pragma unroll
        for (int bj = 0; bj < 2; ++bj)
#pragma unroll
            for (int n = 0; n < 2; ++n) gv[bj][n] = *(const f32x4*)(g1 + u.colbase + bj * HALF + wc * 32 + n * 16 + fq * 4);
#pragma unroll
        for (int ai = 0; ai < 2; ++ai) { f32x4 xv[4][2][2];
#pragma unroll
            for (int m = 0; m < 4; ++m) { const float* xs = xs0 + (size_t)(ai * HALF + wr * 64 + m * 16 + fr) * D;
#pragma unroll
                for (int bj = 0; bj < 2; ++bj)
#pragma unroll
                    for (int n = 0; n < 2; ++n) xv[m][bj][n] = *(const f32x4*)(xs + u.colbase + bj * HALF + wc * 32 + n * 16 + fq * 4); }
#pragma unroll
            for (int m = 0; m < 4; ++m) { float* xb = (float*)(p.ws + WS_XB) + (size_t)(u.rowbase + ai * HALF + wr * 64 + m * 16 + fr) * D;
#pragma unroll
                for (int bj = 0; bj < 2; ++bj)
#pragma unroll
                    for (int n = 0; n < 2; ++n) *(f32x4*)(xb + u.colbase + bj * HALF + wc * 32 + n * 16 + fq * 4) = xv[m][bj][n] + gv[bj][n] * acc[ai][bj][m][n]; } } } };
#endif

struct EpiGu { static constexpr bool PERM = true; bf16* ACT; const float* b_gu;
    struct Pre { f32x4 bv[4]; };
    __device__ __forceinline__ void prefetch(const GUnit& u, int wc, int fq, Pre& pre) const {
        int lo = wc * 32 + fq * 8; asm volatile("" : "+v"(lo));
        const int ch8 = (u.colbase >> 1) + lo; const float* bp = b_gu + (size_t)u.e * 2 * DEXP + 2 * ch8;
#pragma unroll
        for (int q = 0; q < 4; ++q) pre.bv[q] = *(const f32x4*)(bp + 4 * q); }
    __device__ __forceinline__ void operator()(EPI_ARGS, const Pre& pre) const {
        const int ch8 = (u.colbase >> 1) + wc * 32 + fq * 8;
        EPI_ROWS { const int row = u.rowbase + ai * HALF + wr * 64 + m * 16 + fr; f32x4 o[2];
#pragma unroll
            for (int n = 0; n < 2; ++n)
#pragma unroll
                for (int j = 0; j < 4; ++j) { const int c = n * 4 + j; float g = acc[ai][0][m][n][j] + pre.bv[c >> 1][(c & 1) * 2], uu = acc[ai][1][m][n][j] + pre.bv[c >> 1][(c & 1) * 2 + 1];
                    g = fminf(g, 7.f); uu = fminf(fmaxf(uu, -7.f), 7.f); o[n][j] = (uu + 1.f) * (g * sigmoidf_(1.702f * g)); }
            *(u32x4*)(ACT + (size_t)row * DEXP + ch8) = pack8(o[0], o[1]); __builtin_amdgcn_sched_barrier(0); } } };

struct EpiDn { static constexpr bool PERM = true; bf16* YM; const float* b_dn;
    struct Pre { f32x4 bv[2][2]; };
    __device__ __forceinline__ void prefetch(const GUnit& u, int wc, int fq, Pre& pre) const {
#pragma unroll
        for (int bj = 0; bj < 2; ++bj) { int lo = wc * 32 + fq * 8; asm volatile("" : "+v"(lo));
            const float* bp = b_dn + (size_t)u.e * D + u.colbase + bj * HALF + lo; pre.bv[bj][0] = *(const f32x4*)bp; pre.bv[bj][1] = *(const f32x4*)(bp + 4); } }
    __device__ __forceinline__ void operator()(EPI_ARGS, const Pre& pre) const {
        EPI_ROWS { const int row = u.rowbase + ai * HALF + wr * 64 + m * 16 + fr;
#pragma unroll
            for (int bj = 0; bj < 2; ++bj) { const int c8 = u.colbase + bj * HALF + wc * 32 + fq * 8;
                *(u32x4*)(YM + (size_t)row * D + c8) = pack8(acc[ai][bj][m][0] + pre.bv[bj][0], acc[ai][bj][m][1] + pre.bv[bj][1]); } } } };

#define LDS_WAIT() asm volatile("s_waitcnt lgkmcnt(0)" ::: "memory")
struct ConvD { const float* W; const float* scale; bf16* WT; int ldw, ldd, koff, k0, n0, srccol, gu; };
__device__ __forceinline__ void conv_load(const ConvD& d, float (&v)[32], int lane) {
#pragma unroll
    for (int i = 0; i < 32; ++i) { const int kk = 2 * i + (lane >> 5); v[i] = d.srccol >= 0 ? d.W[(size_t)(d.k0 + kk) * d.ldw + d.srccol] : 0.f; }
}
__device__ __forceinline__ void conv_finish(const ConvD& d, const float (&v)[32], LAS float* scr, int lane) {
#pragma unroll
    for (int i = 0; i < 32; ++i) { const int kk = 2 * i + (lane >> 5); scr[kk * 33 + (lane & 31)] = d.scale ? v[i] * d.scale[d.k0 + kk] : v[i]; }
    LDS_WAIT();
    const int c = lane & 7;
#pragma unroll
    for (int j = 0; j < 4; ++j) { const int n = (lane >> 3) + 8 * j; const LAS float* s = scr + (8 * c) * 33 + n;
        u32x4 o; o.x = cvt_pk_bf16(s[0 * 33], s[1 * 33]); o.y = cvt_pk_bf16(s[2 * 33], s[3 * 33]); o.z = cvt_pk_bf16(s[4 * 33], s[5 * 33]); o.w = cvt_pk_bf16(s[6 * 33], s[7 * 33]);
        const int drow = d.gu ? d.n0 + (n & 1) * 128 + (n >> 1) : d.n0 + n;
        *(u32x4*)(d.WT + (size_t)drow * d.ldd + d.koff + d.k0 + 8 * c) = o; }
    LDS_WAIT();
}
__device__ __forceinline__ ConvD conv_dense_desc(const Ptrs& p, int it, int lane) {
    constexpr int I_WIN = 16 * 208, I_QUP = 6 * 24, I_KVUP = 4 * 32, I_BR = 8 * 32, I_OUT = 16 * 32;
    constexpr int PER_L = I_WIN + I_QUP + I_KVUP + 3 * I_BR + I_OUT;
    const int l = it / PER_L; int r = it % PER_L; ConvD d;
    if (r < I_WIN) { const int kb = r / 208, nb = r % 208, n = nb * 32 + (lane & 31);
        d = ConvD{p.w_in + (size_t)l * D * DIN, nullptr, (bf16*)(p.ws + WS_WIN) + (size_t)l * LDP * D, DIN, D, 0, kb * 64, nb * 32, n < DIN ? n : -1, 0}; return d; } r -= I_WIN;
    if (r < I_QUP) { const int kb = r / 24, nb = r % 24;
        d = ConvD{p.w_q_up + (size_t)l * 384 * 768, p.q_norm_g + l * 384, (bf16*)(p.ws + WS_WQUP) + (size_t)l * 768 * 384, 768, 384, 0, kb * 64, nb * 32, nb * 32 + (lane & 31), 0}; return d; } r -= I_QUP;
    if (r < I_KVUP) { const int kb = r / 32, nb = r % 32;
        d = ConvD{p.w_kv_up + (size_t)l * 256 * 1024, p.kv_norm_g + l * 256, (bf16*)(p.ws + WS_WKVUP) + (size_t)l * 1024 * 256, 1024, 256, 0, kb * 64, nb * 32, nb * 32 + (lane & 31), 0}; return d; } r -= I_KVUP;
    if (r < 3 * I_BR) { const int i = r / I_BR, q = r % I_BR, kb = q / 32, nb = q % 32;
        d = ConvD{p.w_branch + ((size_t)l * 3 + i) * 512 * D, nullptr, (bf16*)(p.ws + WS_WBR) + ((size_t)l * 3 + i) * D * 512, D, 512, 0, kb * 64, nb * 32, nb * 32 + (lane & 31), 0}; return d; } r -= 3 * I_BR;
    { const int kb = r / 32, nb = r % 32;
        d = ConvD{p.w_out + (size_t)l * D * D, nullptr, (bf16*)(p.ws + WS_WOUT) + (size_t)l * D * D, D, D, 0, kb * 64, nb * 32, nb * 32 + (lane & 31), 0}; return d; }
}
__device__ __forceinline__ ConvD conv_moe_desc(const Ptrs& p, int l, int it, int lane) {
    constexpr int I_GU = 16 * 64, I_DN = 16 * 32;
    const int e = it / (I_GU + I_DN); int r = it % (I_GU + I_DN);
    if (r < I_GU) { const int kb = r / 64, nb = r % 64;
        return ConvD{p.w_gu + ((size_t)l * NEXP + e) * D * 2 * DEXP, nullptr, (bf16*)(p.ws + WS_WGU) + (size_t)e * 2 * DEXP * D, 2 * DEXP, D, 0, kb * 64, (nb >> 3) * 256 + (nb & 7) * 16, nb * 32 + (lane & 31), 1}; }
    r -= I_GU; { const int kb = r / 32, nb = r % 32;
        return ConvD{p.w_dn + ((size_t)l * NEXP + e) * DEXP * D, nullptr, (bf16*)(p.ws + WS_WDN) + (size_t)e * D * DEXP, D, DEXP, 0, kb * 64, nb * 32, nb * 32 + (lane & 31), 0}; }
}
template <class DescF>
__device__ __forceinline__ void conv_run(int nitems, LAS float* scr, int gw, int NGW, int lane, const DescF& desc) {
    float v0[32], v1[32], v2[32], v3[32];
    ConvD d0, d1, d2, d3;
    int it = gw; if (it >= nitems) return;
    d0 = desc(it); d1 = d0; d2 = d0; d3 = d0;
    conv_load(d0, v0, lane);
    if (it + NGW < nitems) { d1 = desc(it + NGW); conv_load(d1, v1, lane); }
    if (it + 2 * NGW < nitems) { d2 = desc(it + 2 * NGW); conv_load(d2, v2, lane); }
    for (;;) {
        if (it + 3 * NGW < nitems) { d3 = desc(it + 3 * NGW); conv_load(d3, v3, lane); }
        conv_finish(d0, v0, scr, lane); it += NGW; if (it >= nitems) break;
        if (it + 3 * NGW < nitems) { d0 = desc(it + 3 * NGW); conv_load(d0, v0, lane); }
        conv_finish(d1, v1, scr, lane); it += NGW; if (it >= nitems) break;
        if (it + 3 * NGW < nitems) { d1 = desc(it + 3 * NGW); conv_load(d1, v1, lane); }
        conv_finish(d2, v2, scr, lane); it += NGW; if (it >= nitems) break;
        if (it + 3 * NGW < nitems) { d2 = desc(it + 3 * NGW); conv_load(d2, v2, lane); }
        conv_finish(d3, v3, scr, lane); it += NGW; if (it >= nitems) break;
    }
}
__device__ __forceinline__ void conv_dense_weights(const Ptrs& p, LAS float* scr, int gw, int NGW, int lane) {
    constexpr int PER_L = 16 * 208 + 6 * 24 + 4 * 32 + 3 * 8 * 32 + 16 * 32;
    conv_run(2 * PER_L, scr, gw, NGW, lane, [&](int it) { return conv_dense_desc(p, it, lane); });
}
__device__ __forceinline__ void conv_moe_weights(const Ptrs& p, int l, LAS float* scr, int gw, int NGW, int lane) {
    conv_run(NEXP * (16 * 64 + 16 * 32), scr, gw, NGW, lane, [&](int it) { return conv_moe_desc(p, l, it, lane); });
}
__device__ __forceinline__ void rope_tables(const Ptrs& p, int gtid, int NT) {
    float2* rs = (float2*)(p.ws + WS_ROPES); float2* rm = (float2*)(p.ws + WS_ROPEM);
    for (int i = gtid; i < SEQ * 32; i += NT) { const int t = i >> 5, j = i & 31; const float inv = powf(10000.f, -(float)(j & 15) / 16.f); const float ang = (j < 16 ? (float)(t / 64) : (float)(t % 64)) * inv; rs[i] = make_float2(cosf(ang), sinf(ang)); }
    for (int i = gtid; i < SEQ * 16; i += NT) { const int t = i >> 4, j = i & 15; const float inv = powf(10000.f, -(float)(j & 7) / 8.f); const float ang = (j < 8 ? (float)(t / 64) : (float)(t % 64)) * inv; rm[i] = make_float2(cosf(ang), sinf(ang)); }
}
__device__ __forceinline__ void mod_phase(const Ptrs& p, LAS float* lds, int G, int w) {
    LAS float* sc = lds;
    LAS float* red = lds + 1024 * 20;
    const int lane = lane_id(), tid = w * 64 + lane;
    for (int i = tid; i < 17 * D; i += NTHR) { const int r = i / D, k = i % D; const float v = r < NB ? p.c[(size_t)r * D + k] : p.c_ctx[k]; sc[k * 20 + r] = siluf_(v); }
    __syncthreads();
    for (int it = blockIdx.x; it < 2 * 96; it += G) { const int l = it / 96, n = (it % 96) * 64 + lane;
        const float* wm = p.w_mod + (size_t)l * D * 6 * D + n; float acc[17];
#pragma unroll
        for (int r = 0; r < 17; ++r) acc[r] = 0.f;
        float wv[128];
#pragma unroll
        for (int j = 0; j < 128; ++j) wv[j] = wm[(size_t)(w * 128 + j) * 6 * D];
#pragma unroll
        for (int j = 0; j < 128; ++j) { const LAS float* s = sc + (w * 128 + j) * 20;
#pragma unroll
            for (int r = 0; r < 17; ++r) acc[r] = fmaf(s[r], wv[j], acc[r]); }
#pragma unroll
        for (int r = 0; r < 17; ++r) red[(w * 17 + r) * 64 + lane] = acc[r];
        __syncthreads();
        for (int i = tid; i < 17 * 64; i += NTHR) { const int r = i >> 6, c = i & 63; float s = 0.f;
#pragma unroll
            for (int ww = 0; ww < 8; ++ww) s += red[(ww * 17 + r) * 64 + c];
            ((float*)(p.ws + WS_MOD))[((size_t)l * 17 + r) * 6 * D + (it % 96) * 64 + c] = s + p.b_mod[(size_t)l * 6 * D + (it % 96) * 64 + c]; }
        __syncthreads();
    }
}

__device__ __forceinline__ void norm1_rows2(const Ptrs& p, int l, int mode, int rowA, int rowB, int lane, const LAS int* ps) {
    const bool combine = (l > 0);
    const int rows[2] = {rowA, rowB < 0 ? rowA : rowB};
    float v[2][16], m[2][16];
#pragma unroll
    for (int q = 0; q < 2; ++q) {
#if XB_BF16 && !defined(XB_NON1L)
        if (l >= 1) { const bf16* src = (const bf16*)(p.ws + WS_XB) + (size_t)rows[q] * D;
#pragma unroll
            for (int j = 0; j < 4; ++j) { const uint2 t = *(const uint2*)(src + j * 256 + lane * 4);
                v[q][4 * j] = __uint_as_float(t.x << 16); v[q][4 * j + 1] = __uint_as_float(t.x & 0xffff0000u); v[q][4 * j + 2] = __uint_as_float(t.y << 16); v[q][4 * j + 3] = __uint_as_float(t.y & 0xffff0000u); } }
        else
#endif
        { const float* src = xrow_src(p, l >= 1 ? 1 : 0, rows[q]);
#pragma unroll
        for (int j = 0; j < 4; ++j) { const float4 t = *(const float4*)(src + j * 256 + lane * 4); v[q][4 * j] = t.x; v[q][4 * j + 1] = t.y; v[q][4 * j + 2] = t.z; v[q][4 * j + 3] = t.w; } } }
    if (combine) {
        const int lp = l - 1;
        int4 te[2], tp[2]; float4 tg[2];
#pragma unroll
        for (int q = 0; q < 2; ++q) { te[q] = *(const int4*)((const int*)(p.ws + WS_TOPE) + (size_t)rows[q] * 4); tp[q] = *(const int4*)((const int*)(p.ws + WS_TOPP) + (size_t)rows[q] * 4);
            tg[q] = *(const float4*)((const float*)(p.ws + WS_TOPG) + (size_t)rows[q] * 4); }
        uint2 yv[2][4][4];
#pragma unroll
        for (int q = 0; q < 2; ++q) { const int ee[4] = {te[q].x, te[q].y, te[q].z, te[q].w}, pp[4] = {tp[q].x, tp[q].y, tp[q].z, tp[q].w};
#pragma unroll
            for (int k = 0; k < 4; ++k) { const bf16* y = (const bf16*)(p.ws + WS_YM) + (size_t)(ps[ee[k]] + pp[k]) * D;
#pragma unroll
                for (int j = 0; j < 4; ++j) yv[q][k][j] = *(const uint2*)(y + j * 256 + lane * 4); } }
#pragma unroll
        for (int q = 0; q < 2; ++q) { const float gg[4] = {tg[q].x, tg[q].y, tg[q].z, tg[q].w};
            const float* modv = (const float*)(p.ws + WS_MOD) + ((size_t)lp * 17 + mod_row(rows[q])) * 6 * D + 5 * D;
#pragma unroll
            for (int i = 0; i < 16; ++i) m[q][i] = 0.f;
#pragma unroll
            for (int k = 0; k < 4; ++k)
#pragma unroll
                for (int j = 0; j < 4; ++j) { const uint2 t = yv[q][k][j]; const float g = gg[k];
                    m[q][4 * j] += g * __uint_as_float(t.x << 16); m[q][4 * j + 1] += g * __uint_as_float(t.x & 0xffff0000u); m[q][4 * j + 2] += g * __uint_as_float(t.y << 16); m[q][4 * j + 3] += g * __uint_as_float(t.y & 0xffff0000u); }
#pragma unroll
            for (int j = 0; j < 4; ++j) { const float4 g2 = *(const float4*)(modv + j * 256 + lane * 4);
                v[q][4 * j] += g2.x * m[q][4 * j]; v[q][4 * j + 1] += g2.y * m[q][4 * j + 1]; v[q][4 * j + 2] += g2.z * m[q][4 * j + 2]; v[q][4 * j + 3] += g2.w * m[q][4 * j + 3]; } }
#if !XB_BF16 || defined(XB_NON1S)
        if (mode != 2) {
#pragma unroll
            for (int q = 0; q < 2; ++q) if (q == 0 || rowB >= 0) { float* xb = (float*)(p.ws + WS_XB) + (size_t)rows[q] * D;
#pragma unroll
                for (int j = 0; j < 4; ++j) *(float4*)(xb + j * 256 + lane * 4) = make_float4(v[q][4 * j], v[q][4 * j + 1], v[q][4 * j + 2], v[q][4 * j + 3]); } }
#endif
    }
#if XB_BF16 && !defined(XB_NON1S)
    if (mode != 2) {
#pragma unroll
        for (int q = 0; q < 2; ++q) if (q == 0 || rowB >= 0) { bf16* xb = (bf16*)(p.ws + WS_XB) + (size_t)rows[q] * D;
#pragma unroll
            for (int j = 0; j < 4; ++j) *(uint2*)(xb + j * 256 + lane * 4) = make_uint2(cvt_pk_bf16(v[q][4 * j], v[q][4 * j + 1]), cvt_pk_bf16(v[q][4 * j + 2], v[q][4 * j + 3])); } }
#endif
    float r[2];
#pragma unroll
    for (int q = 0; q < 2; ++q) { float s = 0.f;
#pragma unroll
        for (int i = 0; i < 16; ++i) s += v[q][i] * v[q][i];
        r[q] = rsqrtf(wave_sum(s) * (1.f / D) + EPS); }
#pragma unroll
    for (int q = 0; q < 2; ++q) if (q == 0 || rowB >= 0) {
        if (mode == 2) {
            float* o = p.out + (size_t)rows[q] * D;
#pragma unroll
            for (int j = 0; j < 4; ++j) { const float4 g = *(const float4*)(p.final_g + j * 256 + lane * 4);
                *(float4*)(o + j * 256 + lane * 4) = make_float4(v[q][4 * j] * r[q] * g.x, v[q][4 * j + 1] * r[q] * g.y, v[q][4 * j + 2] * r[q] * g.z, v[q][4 * j + 3] * r[q] * g.w); }
        } else {
            const float* ng = p.norm1_g + (size_t)l * D;
            const float* modv = (const float*)(p.ws + WS_MOD) + ((size_t)l * 17 + mod_row(rows[q])) * 6 * D;
            bf16* h = (bf16*)(p.ws + WS_H) + (size_t)rows[q] * D;
#pragma unroll
            for (int j = 0; j < 4; ++j) { const int c = j * 256 + lane * 4; const float4 g = *(const float4*)(ng + c), sh = *(const float4*)(modv + c), sc = *(const float4*)(modv + D + c);
                *(uint2*)(h + c) = make_uint2(cvt_pk_bf16(v[q][4 * j] * r[q] * g.x * (1.f + sc.x) + sh.x, v[q][4 * j + 1] * r[q] * g.y * (1.f + sc.y) + sh.y),
                                              cvt_pk_bf16(v[q][4 * j + 2] * r[q] * g.z * (1.f + sc.z) + sh.z, v[q][4 * j + 3] * r[q] * g.w * (1.f + sc.w) + sh.w)); }
        }
    }
}

__device__ __forceinline__ void prep_row(const Ptrs& p, int l, int row, int lane) {
    const bf16* P = (const bf16*)(p.ws + WS_P) + (size_t)row * LDP;
    const bool lat = row < NLAT; const int t = lat ? row % SEQ : (row - NLAT) % CTXL, slen = lat ? SEQ : CTXL;
    { float s = 0.f;
#pragma unroll
      for (int j = 0; j < 6; ++j) { const float v = bf2f(P[C_CQ + lane + 64 * j]); s += v * v; }
      s = wave_sum(s); if (lane == 0) ((float*)(p.ws + WS_RQ))[row] = rsqrtf(s * (1.f / 384.f) + EPS);
      s = 0.f;
#pragma unroll
      for (int j = 0; j < 4; ++j) { const float v = bf2f(P[C_CKV + lane + 64 * j]); s += v * v; }
      s = wave_sum(s); if (lane == 0) ((float*)(p.ws + WS_RKV))[row] = rsqrtf(s * (1.f / 256.f) + EPS); }
    { bf16* QS = (bf16*)(p.ws + WS_QS) + (size_t)row * 512; bf16* KS = (bf16*)(p.ws + WS_KS) + (size_t)row * 128; const float2* rs = (const float2*)(p.ws + WS_ROPES) + (size_t)t * 32;
#pragma unroll
      for (int it = 0; it < 5; ++it) { const int pi = lane + 64 * it; const bool isq = pi < 256; const int hh = isq ? pi / 32 : (pi - 256) / 32, i = pi % 32;
        const bf16* src = P + (isq ? C_SQ : C_SK) + hh * 64; bf16* dst = (isq ? QS : KS) + hh * 64;
        const float x1 = bf2f(src[i]), x2 = bf2f(src[i + 32]); float2 cs = make_float2(1.f, 0.f); if (lat) cs = rs[i];
        dst[i] = f2bf(x1 * cs.x - x2 * cs.y); dst[i + 32] = f2bf(x2 * cs.x + x1 * cs.y); } }
    if (lane < 16) { const int i = lane; const float x1 = bf2f(P[C_KR + i]), x2 = bf2f(P[C_KR + i + 16]);
        float2 cs = make_float2(1.f, 0.f); if (lat) cs = ((const float2*)(p.ws + WS_ROPEM))[(size_t)t * 16 + i];
        const bf16 o1 = f2bf(x1 * cs.x - x2 * cs.y), o2 = f2bf(x2 * cs.x + x1 * cs.y);
        bf16* KM = (bf16*)(p.ws + WS_KM) + (size_t)row * 768;
#pragma unroll
        for (int h = 0; h < 8; ++h) { KM[h * 96 + 64 + i] = o1; KM[h * 96 + 80 + i] = o2; } }
    { const float* cw = p.conv_w + (size_t)l * 5 * 1536;
      bf16* DQ = (bf16*)(p.ws + WS_DQ) + (size_t)row * 512; bf16* DK = (bf16*)(p.ws + WS_DK) + (size_t)row * 512; bf16* DV = (bf16*)(p.ws + WS_DV) + (size_t)row * 512;
#pragma unroll 4
      for (int j = 0; j < 24; ++j) { const int c = lane + 64 * j; float y = 0.f;
#pragma unroll
        for (int tap = 0; tap < 5; ++tap) { const int tt = t + tap - 2; if (tt >= 0 && tt < slen) y += bf2f(P[(ptrdiff_t)(tap - 2) * LDP + C_DQKV + c]) * cw[tap * 1536 + c]; }
        y = siluf_(y);
        if (j < 16) { const float ss = wave_sum(y * y); y *= rsqrtf(ss + EPS); if (j < 8) y *= 0.125f; }
        if (j < 8) DQ[c] = f2bf(y); else if (j < 16) DK[c - 512] = f2bf(y); else DV[c - 1024] = f2bf(y); } }
    if (lane < 16) { const float braw = bf2f(P[C_DBETA + lane]), araw = bf2f(P[C_DA + lane]);
        ((float*)(p.ws + WS_DB))[(size_t)row * 16 + lane] = sigmoidf_(braw);
        ((float*)(p.ws + WS_DG))[(size_t)row * 16 + lane] = -__expf(p.a_log[l * 16 + lane]) * softplusf_(araw + p.dt_bias[l * 16 + lane]); }
}

__device__ __forceinline__ void dnpost_row(const Ptrs& p, int l, int row, int lane) {
    const bf16* o0 = (const bf16*)(p.ws + WS_DO) + (size_t)row * 512 + lane * 8; const bf16* o1 = o0 + (size_t)NTOK * 512;
    float fa[8], fb[8]; unpack8(*(const u32x4*)o0, fa); unpack8(*(const u32x4*)o1, fb);
    float v[8]; float s = 0.f;
#pragma unroll
    for (int i = 0; i < 8; ++i) v[i] = fa[i] + fb[i];
#pragma unroll
    for (int i = 0; i < 8; ++i) s += v[i] * v[i];
    s += __shfl_xor(s, 1); s += __shfl_xor(s, 2); s += __shfl_xor(s, 4);
    const float r = rsqrtf(s * (1.f / 64.f) + EPS);
    float z[8]; unpack8(*(const u32x4*)((const bf16*)(p.ws + WS_P) + (size_t)row * LDP + C_DZ + lane * 8), z); const float* ng = p.dn_norm_g + l * 64 + (lane & 7) * 8;
    float o[8];
#pragma unroll
    for (int i = 0; i < 8; ++i) o[i] = v[i] * r * ng[i] * siluf_(z[i]);
    u32x4 w; w.x = cvt_pk_bf16(o[0], o[1]); w.y = cvt_pk_bf16(o[2], o[3]); w.z = cvt_pk_bf16(o[4], o[5]); w.w = cvt_pk_bf16(o[6], o[7]);
    *(u32x4*)((bf16*)(p.ws + WS_BR) + (size_t)2 * NTOK * 512 + (size_t)row * 512 + lane * 8) = w;
}

#ifndef RTR_WREG
#define RTR_WREG 1
#endif
__device__ __forceinline__ void router_phase(const Ptrs& p, int l, int nrows, LAS unsigned char* lds, int G, int w) {
    LAS float* hrow = (LAS float*)lds;
    LAS unsigned* hist = (LAS unsigned*)(lds + 32768); LAS unsigned* base = hist + NEXP;
    LAS int* se = (LAS int*)(lds + 32768 + 256); LAS int* sp = se + 1024;
    const int lane = lane_id(), tid = w * 64 + lane;
    const int rpb = (nrows + G - 1) / G, r0 = blockIdx.x * rpb, r1 = min(nrows, r0 + rpb);
    if (tid < NEXP) hist[tid] = 0u;
    __syncthreads();
    const float* rw = p.router_w + (size_t)l * D * NEXP; const float* rb = p.router_b + l * NEXP;
    unsigned* cnt = (unsigned*)(p.ws + WS_CTL) + CW_CNT + 32 * l;
    int* TE = (int*)(p.ws + WS_TOPE); int* TP = (int*)(p.ws + WS_TOPP); float* TG = (float*)(p.ws + WS_TOPG);
    for (int row = r0 + w; row < r1; row += NWAVES) { const int rr = row - r0;
        const float* src = (const float*)(p.ws + WS_XB) + (size_t)row * D;
        float v[16]; float s = 0.f;
#pragma unroll
        for (int j = 0; j < 4; ++j) { const float4 t4 = *(const float4*)(src + j * 256 + lane * 4); v[4 * j] = t4.x; v[4 * j + 1] = t4.y; v[4 * j + 2] = t4.z; v[4 * j + 3] = t4.w; }
#pragma unroll
        for (int i = 0; i < 16; ++i) s += v[i] * v[i];
        const float r = rsqrtf(wave_sum(s) * (1.f / D) + EPS);
        const float* ng = p.norm2_g + (size_t)l * D; const float* modv = (const float*)(p.ws + WS_MOD) + ((size_t)l * 17 + mod_row(row)) * 6 * D + 3 * D;
        bf16* h = (bf16*)(p.ws + WS_H) + (size_t)row * D;
#pragma unroll
        for (int j = 0; j < 4; ++j) { const int c = j * 256 + lane * 4; const float4 g = *(const float4*)(ng + c), sh = *(const float4*)(modv + c), sc = *(const float4*)(modv + D + c);
            const float o0 = v[4 * j] * r * g.x * (1.f + sc.x) + sh.x, o1 = v[4 * j + 1] * r * g.y * (1.f + sc.y) + sh.y, o2 = v[4 * j + 2] * r * g.z * (1.f + sc.z) + sh.z, o3 = v[4 * j + 3] * r * g.w * (1.f + sc.w) + sh.w;
            *(LAS f32x4*)(hrow + w * D + c) = (f32x4){o0, o1, o2, o3};
            *(uint2*)(h + c) = make_uint2(cvt_pk_bf16(o0, o1), cvt_pk_bf16(o2, o3)); }
        LDS_WAIT();
        const int e = lane & 31, kh = lane >> 5; float acc = 0.f;
        const LAS float* hr = hrow + w * D + kh * 512; const float* rwp = rw + (size_t)kh * 512 * NEXP + e;
#pragma unroll 8
        for (int k = 0; k < 512; ++k) acc = fmaf(hr[k], rwp[(size_t)k * NEXP], acc);
        acc += __shfl_xor(acc, 32); acc += rb[e];
        float cur = acc, myv = 0.f, mx = 0.f, den = 0.f; int mye = 0;
#pragma unroll
        for (int k = 0; k < 4; ++k) { float bv = cur; int be = e;
#pragma unroll
            for (int o = 1; o < 32; o <<= 1) { const float ov = __shfl_xor(bv, o); const int oe = __shfl_xor(be, o); if (ov > bv || (ov == bv && oe < be)) { bv = ov; be = oe; } }
            if (k == 0) mx = bv;
            const float ex = __expf(bv - mx); den += ex;
            if (lane == k) { myv = ex; mye = be; }
            if (e == be) cur = -3.0e38f; }
        if (lane < 4) { const int k = lane;
            TE[(size_t)row * 4 + k] = mye; TG[(size_t)row * 4 + k] = myv / den; se[rr * 4 + k] = mye; sp[rr * 4 + k] = (int)__hip_atomic_fetch_add(&hist[mye], 1u, __ATOMIC_RELAXED, __HIP_MEMORY_SCOPE_WORKGROUP); }
    }
    __syncthreads();
    if (tid < NEXP) base[tid] = atomicAdd(&cnt[tid], hist[tid]);
    __syncthreads();
    int* LIST = (int*)(p.ws + WS_LIST);
    for (int i = tid; i < (r1 - r0) * 4; i += NTHR) { const int row = r0 + (i >> 2); const int e = se[i]; const int pos = sp[i] + (int)base[e];
        TP[(size_t)row * 4 + (i & 3)] = pos; LIST[(size_t)e * NTOK + pos] = row; }
    __syncthreads();
}

template <int DK, int MODE>
__device__ __forceinline__ void attn_wave(const Ptrs& p, int l, int ctxq, int qb, int h, int b, LAS float* wl, int lane) {
    constexpr int DV = 64, KT = 16;
    LAS float* Ks = wl; LAS float* Vs = wl + KT * DK;
    const int t = qb * 64 + lane, qrow = ctxq ? NLAT + b * CTXL + t : b * SEQ + t;
    const bf16* Qp = MODE == 0 ? (const bf16*)(p.ws + WS_QM) + (size_t)qrow * 768 + h * 96 : (const bf16*)(p.ws + WS_QS) + (size_t)qrow * 512 + h * 64;
    const float scale = MODE == 0 ? 0.10206207261596575f : 0.125f;
    float q[DK], o[DV];
#pragma unroll
    for (int i = 0; i < DK; ++i) q[i] = bf2f(Qp[i]) * scale;
#pragma unroll
    for (int i = 0; i < DV; ++i) o[i] = 0.f;
    float m = -1e30f, lsum = 0.f;
    if (MODE == 1) { m = p.sink[l * 8 + h]; lsum = 1.f; }
    if (MODE == 0 && !ctxq) { const float2* tab = (const float2*)(p.ws + WS_ROPEM) + (size_t)t * 16;
#pragma unroll
        for (int i = 0; i < 16; ++i) { const float2 cs = tab[i]; const float x1 = q[DK - 32 + i], x2 = q[DK - 16 + i]; q[DK - 32 + i] = x1 * cs.x - x2 * cs.y; q[DK - 16 + i] = x2 * cs.x + x1 * cs.y; } }
    for (int seg = 0; seg < (ctxq ? 1 : 2); ++seg) {
        int k0 = 0, k1 = CTXL; if (seg == 1) { k0 = 0; k1 = SEQ; if (MODE == 1) { k0 = max(0, qb * 64 - 128); k1 = min(SEQ, qb * 64 + 64 + 128); } }
        const int rbase = seg == 0 ? NLAT + b * CTXL : b * SEQ;
        for (int kt = k0; kt < k1; kt += KT) {
            LDS_WAIT();
            for (int e = lane; e < KT * DK; e += 64) { const int kk = e / DK, d = e % DK; const int row = rbase + kt + kk;
                Ks[kk * DK + d] = MODE == 0 ? bf2f(((const bf16*)(p.ws + WS_KM))[(size_t)row * 768 + h * 96 + d]) : bf2f(((const bf16*)(p.ws + WS_KS))[(size_t)row * 128 + (h >> 2) * 64 + d]); }
            for (int e = lane; e < KT * DV; e += 64) { const int kk = e / DV, d = e % DV; const int row = rbase + kt + kk;
                Vs[kk * DV + d] = MODE == 0 ? bf2f(((const bf16*)(p.ws + WS_VM))[(size_t)row * 512 + h * 64 + d]) : bf2f(((const bf16*)(p.ws + WS_P))[(size_t)row * LDP + C_SV + (h >> 2) * 64 + d]); }
            LDS_WAIT();
            for (int kk = 0; kk < KT; ++kk) {
                if (MODE == 1 && seg == 1) { const int dlt = kt + kk - t; if (dlt > 128 || dlt < -128) continue; }
                float s = 0.f;
#pragma unroll
                for (int i = 0; i < DK; ++i) s = fmaf(q[i], Ks[kk * DK + i], s);
                const float mn = fmaxf(m, s), c = __expf(m - mn), pe = __expf(s - mn);
                lsum = lsum * c + pe; m = mn;
#pragma unroll
                for (int i = 0; i < DV; ++i) o[i] = fmaf(pe, Vs[kk * DV + i], o[i] * c);
            }
        }
    }
    const float inv = 1.f / lsum;
    bf16* O = (bf16*)(p.ws + WS_BR) + (size_t)(MODE == 0 ? 0 : 1) * NTOK * 512 + (size_t)qrow * 512 + h * 64;
#pragma unroll
    for (int i = 0; i < DV; i += 2) *(unsigned*)(O + i) = cvt_pk_bf16(o[i] * inv, o[i + 1] * inv);
}
__device__ __forceinline__ void dn_scan_wave(const Ptrs& p, int b, int h, int dir, LAS float* wl, int v) {
    constexpr int CH = 16;
    LAS float* qs = wl; LAS float* ks = wl + CH * 64; LAS float* vs = wl + 2 * CH * 64; LAS float* gs = wl + 3 * CH * 64; LAS float* bs = gs + CH; LAS int* rs = (LAS int*)(bs + CH);
    float S[64];
#pragma unroll
    for (int i = 0; i < 64; ++i) S[i] = 0.f;
    float* DO = (float*)(p.ws + WS_DO) + (size_t)dir * NTOK * 512;
    for (int s0 = 0; s0 < CTXL + SEQ; s0 += CH) {
        LDS_WAIT();
        for (int e = v; e < CH * 64; e += 64) { const int i = e >> 6, d = e & 63; const int s = s0 + i;
            const int row = s < CTXL ? NLAT + b * CTXL + (dir ? CTXL - 1 - s : s) : b * SEQ + (dir ? SEQ - 1 - (s - CTXL) : (s - CTXL));
            qs[i * 64 + d] = bf2f(((const bf16*)(p.ws + WS_DQ))[(size_t)row * 512 + h * 64 + d]); ks[i * 64 + d] = bf2f(((const bf16*)(p.ws + WS_DK))[(size_t)row * 512 + h * 64 + d]);
            vs[i * 64 + d] = bf2f(((const bf16*)(p.ws + WS_DV))[(size_t)row * 512 + h * 64 + d]);
            if (d == 0) { rs[i] = row; gs[i] = ((const float*)(p.ws + WS_DG))[(size_t)row * 16 + dir * 8 + h]; bs[i] = ((const float*)(p.ws + WS_DB))[(size_t)row * 16 + dir * 8 + h]; } }
        LDS_WAIT();
        for (int i = 0; i < CH; ++i) {
            float kS = 0.f;
#pragma unroll
            for (int k = 0; k < 64; ++k) kS = fmaf(ks[i * 64 + k], S[k], kS);
            const float a = __expf(gs[i]), dl = bs[i] * (vs[i * 64 + v] - a * kS);
            float o = 0.f;
#pragma unroll
            for (int k = 0; k < 64; ++k) { S[k] = fmaf(ks[i * 64 + k], dl, a * S[k]); o = fmaf(qs[i * 64 + k], S[k], o); }
            DO[(size_t)rs[i] * 512 + h * 64 + v] = o;
        }
    }
}
__device__ __forceinline__ void mixers_valu_phase(const Ptrs& p, int l, LAS unsigned char* lds, int gw, int NGW, int wave, int lane) {
    LAS float* wl = (LAS float*)(lds + wave * 16384);
    const int n_lat = SEQ / 64 * 8 * NB, n_ctx = l == 0 ? CTXL / 64 * 8 * NB : 0;
    for (int r = gw; r < 256; r += NGW) dn_scan_wave(p, r & 15, (r >> 4) & 7, r >> 7, wl, lane);
    for (int r = gw; r < n_lat; r += NGW) attn_wave<96, 0>(p, l, 0, r & 31, (r >> 5) & 7, r >> 8, wl, lane);
    for (int r = gw; r < n_lat; r += NGW) attn_wave<64, 1>(p, l, 0, r & 31, (r >> 5) & 7, r >> 8, wl, lane);
    for (int r = gw; r < n_ctx; r += NGW) attn_wave<96, 0>(p, l, 1, r & 3, (r >> 2) & 7, r >> 5, wl, lane);
    for (int r = gw; r < n_ctx; r += NGW) attn_wave<64, 1>(p, l, 1, r & 3, (r >> 2) & 7, r >> 5, wl, lane);
}

__device__ __forceinline__ void prep_phase2(const Ptrs& p, int l, int gw, int NGW, int lane) {
    const bf16* Pb = (const bf16*)(p.ws + WS_P);
    constexpr int N_CONV = (NTOK / 64) * 3, N_MISC = NTOK / 16;
    for (int it = gw; it < N_CONV + N_MISC; it += NGW) {
        if (it < N_CONV) {
            const int part = it % 3, row0 = (it / 3) * 64; const bool lat = row0 < NLAT; const int t0 = lat ? row0 % SEQ : (row0 - NLAT) % CTXL, slen = lat ? SEQ : CTXL;
            const int c0 = part * 512 + lane * 8;
            float w[5][8];
#pragma unroll
            for (int tap = 0; tap < 5; ++tap) { const float4 a = *(const float4*)(p.conv_w + (size_t)l * 5 * 1536 + tap * 1536 + c0), b4 = *(const float4*)(p.conv_w + (size_t)l * 5 * 1536 + tap * 1536 + c0 + 4);
                w[tap][0] = a.x; w[tap][1] = a.y; w[tap][2] = a.z; w[tap][3] = a.w; w[tap][4] = b4.x; w[tap][5] = b4.y; w[tap][6] = b4.z; w[tap][7] = b4.w; }
            bf16* dst = (bf16*)(p.ws + (part == 0 ? WS_DQ : part == 1 ? WS_DK : WS_DV)) + lane * 8;
            for (int g8 = 0; g8 < 8; ++g8) {
                u32x4 xr[12];
#pragma unroll
                for (int j = 0; j < 12; ++j) { const int tt = t0 + g8 * 8 + j - 2; xr[j] = (u32x4){0u, 0u, 0u, 0u};
                    if (tt >= 0 && tt < slen) xr[j] = *(const u32x4*)(Pb + (size_t)(row0 + g8 * 8 + j - 2) * LDP + C_DQKV + c0); }
#pragma unroll
                for (int o = 0; o < 8; ++o) { float y[8];
#pragma unroll
                    for (int e = 0; e < 8; ++e) y[e] = 0.f;
#pragma unroll
                    for (int tap = 0; tap < 5; ++tap) { float x8[8]; unpack8(xr[o + tap], x8);
#pragma unroll
                        for (int e = 0; e < 8; ++e) y[e] = fmaf(x8[e], w[tap][e], y[e]); }
                    float ss = 0.f;
#pragma unroll
                    for (int e = 0; e < 8; ++e) { y[e] = siluf_(y[e]); ss += y[e] * y[e]; }
                    if (part < 2) { ss += __shfl_xor(ss, 1); ss += __shfl_xor(ss, 2); ss += __shfl_xor(ss, 4); const float rn = rsqrtf(ss + EPS) * (part == 0 ? 0.125f : 1.f);
#pragma unroll
                        for (int e = 0; e < 8; ++e) y[e] *= rn; }
                    u32x4 wv; wv.x = cvt_pk_bf16(y[0], y[1]); wv.y = cvt_pk_bf16(y[2], y[3]); wv.z = cvt_pk_bf16(y[4], y[5]); wv.w = cvt_pk_bf16(y[6], y[7]);
                    *(u32x4*)(dst + (size_t)(row0 + g8 * 8 + o) * 512) = wv; }
            }
        } else {
            const int row0 = (it - N_CONV) * 16; const bool lat = row0 < NLAT;
            for (int i0 = 0; i0 < 16; i0 += 4) {
                u32x4 ra[4], rb2[4], rq[4], rk[4], rr[4]; float gb[4], ga[4];
#pragma unroll
                for (int u = 0; u < 4; ++u) { const bf16* P = Pb + (size_t)(row0 + i0 + u) * LDP;
                    ra[u] = *(const u32x4*)(P + lane * 8); rb2[u] = *(const u32x4*)(P + 512 + (lane & 15) * 8);
                    rq[u] = *(const u32x4*)(P + C_SQ + lane * 8); rk[u] = *(const u32x4*)(P + C_SK + (lane & 15) * 8); rr[u] = *(const u32x4*)(P + C_KR + (lane & 3) * 8);
                    gb[u] = bf2f(P[C_DBETA + (lane & 15)]); ga[u] = bf2f(P[C_DA + (lane & 15)]); }
#pragma unroll
                for (int u = 0; u < 4; ++u) { const int row = row0 + i0 + u; const int t = lat ? row % SEQ : 0;
                    { float s8[8]; unpack8(ra[u], s8); float s1 = 0.f, s2 = 0.f, ssum = 0.f;
#pragma unroll
                      for (int e = 0; e < 8; ++e) ssum += s8[e] * s8[e];
                      if (lane < 48) s1 = ssum; else s2 = ssum;
                      if (lane < 16) { unpack8(rb2[u], s8);
#pragma unroll
                          for (int e = 0; e < 8; ++e) s2 += s8[e] * s8[e]; }
                      s1 = wave_sum(s1); s2 = wave_sum(s2);
                      if (lane == 0) { ((float*)(p.ws + WS_RQ))[row] = rsqrtf(s1 * (1.f / 384.f) + EPS); ((float*)(p.ws + WS_RKV))[row] = rsqrtf(s2 * (1.f / 256.f) + EPS); } }
                    { float x8[8], p8[8]; const u32x4 raw = rq[u]; unpack8(raw, x8);
                      u32x4 pr; pr.x = __shfl_xor(raw.x, 4); pr.y = __shfl_xor(raw.y, 4); pr.z = __shfl_xor(raw.z, 4); pr.w = __shfl_xor(raw.w, 4); unpack8(pr, p8);
                      const float2* rs = (const float2*)(p.ws + WS_ROPES) + (size_t)t * 32 + (lane & 3) * 8; const float sgn = (lane & 4) ? 1.f : -1.f; float o8[8]; float2 cs8[8];
#pragma unroll
                      for (int e = 0; e < 8; ++e) { cs8[e] = make_float2(1.f, 0.f); if (lat) cs8[e] = rs[e]; o8[e] = x8[e] * cs8[e].x + sgn * p8[e] * cs8[e].y; }
                      u32x4 wv; wv.x = cvt_pk_bf16(o8[0], o8[1]); wv.y = cvt_pk_bf16(o8[2], o8[3]); wv.z = cvt_pk_bf16(o8[4], o8[5]); wv.w = cvt_pk_bf16(o8[6], o8[7]);
                      *(u32x4*)((bf16*)(p.ws + WS_QS) + (size_t)row * 512 + lane * 8) = wv;
                      const u32x4 rawk = rk[u]; unpack8(rawk, x8);
                      pr.x = __shfl_xor(rawk.x, 4); pr.y = __shfl_xor(rawk.y, 4); pr.z = __shfl_xor(rawk.z, 4); pr.w = __shfl_xor(rawk.w, 4); unpack8(pr, p8);
#pragma unroll
                      for (int e = 0; e < 8; ++e) o8[e] = x8[e] * cs8[e].x + sgn * p8[e] * cs8[e].y;
                      wv.x = cvt_pk_bf16(o8[0], o8[1]); wv.y = cvt_pk_bf16(o8[2], o8[3]); wv.z = cvt_pk_bf16(o8[4], o8[5]); wv.w = cvt_pk_bf16(o8[6], o8[7]);
                      if (lane < 16) *(u32x4*)((bf16*)(p.ws + WS_KS) + (size_t)row * 128 + lane * 8) = wv; }
                    { const int ch = lane & 3; float x8[8], p8[8]; const u32x4 raw = rr[u]; unpack8(raw, x8);
                      u32x4 pr; pr.x = __shfl_xor(raw.x, 2); pr.y = __shfl_xor(raw.y, 2); pr.z = __shfl_xor(raw.z, 2); pr.w = __shfl_xor(raw.w, 2); unpack8(pr, p8);
                      const float2* rm = (const float2*)(p.ws + WS_ROPEM) + (size_t)t * 16 + (ch & 1) * 8; const float sgn = (ch & 2) ? 1.f : -1.f; float o8[8];
#pragma unroll
                      for (int e = 0; e < 8; ++e) { float2 cs = make_float2(1.f, 0.f); if (lat) cs = rm[e]; o8[e] = x8[e] * cs.x + sgn * p8[e] * cs.y; }
                      u32x4 wv; wv.x = cvt_pk_bf16(o8[0], o8[1]); wv.y = cvt_pk_bf16(o8[2], o8[3]); wv.z = cvt_pk_bf16(o8[4], o8[5]); wv.w = cvt_pk_bf16(o8[6], o8[7]);
                      if (lane < 32) *(u32x4*)((bf16*)(p.ws + WS_KM) + (size_t)row * 768 + (lane >> 2) * 96 + 64 + ch * 8) = wv; }
                    if (lane < 16) {
                        ((float*)(p.ws + WS_DB))[(size_t)row * 16 + lane] = sigmoidf_(gb[u]);
                        ((float*)(p.ws + WS_DG))[(size_t)row * 16 + lane] = -__expf(p.a_log[l * 16 + lane]) * softplusf_(ga[u] + p.dt_bias[l * 16 + lane]); }
                }
            }
        }
    }
}

__device__ __forceinline__ void router_phase2(const Ptrs& p, int l, int nrows, LAS unsigned char* lds, int G, int w) {
    constexpr int HST = 1028;
    LAS float* hs = (LAS float*)lds;
    LAS float* red = (LAS float*)(lds + 65792);
    LAS unsigned* hist = (LAS unsigned*)(lds + 98560); LAS unsigned* base = hist + NEXP;
    LAS int* se = (LAS int*)(lds + 98560 + 256); LAS int* sp = se + 1024;
    const int lane = lane_id(), tid = w * 64 + lane;
    const int rpb = (nrows + G - 1) / G, r0 = blockIdx.x * rpb, r1 = min(nrows, r0 + rpb);
    if (tid < NEXP) hist[tid] = 0u;
    __syncthreads();
    const float* rw = p.router_w + (size_t)l * D * NEXP; const float* rb = p.router_b + l * NEXP;
    unsigned* cnt = (unsigned*)(p.ws + WS_CTL) + CW_CNT + 32 * l;
    int* TE = (int*)(p.ws + WS_TOPE); int* TP = (int*)(p.ws + WS_TOPP); float* TG = (float*)(p.ws + WS_TOPG);
    const float* ng = p.norm2_g + (size_t)l * D;
#if RTR_WREG
    float rwv[64];
    { const int e_ = lane & 31, kb_ = 128 * w + 64 * (lane >> 5);
#pragma unroll
      for (int kk = 0; kk < 64; ++kk) rwv[kk] = rw[(size_t)(kb_ + kk) * NEXP + e_]; }
#endif
    for (int t0 = r0; t0 < r1; t0 += 16) {
        { float v[2][16];
#pragma unroll
          for (int q = 0; q < 2; ++q) { const int row = min(t0 + 2 * w + q, r1 - 1);
#if XB_BF16 && !defined(XB_NORTR)
              const bf16* src = (const bf16*)(p.ws + WS_XB) + (size_t)row * D;
#pragma unroll
              for (int j = 0; j < 4; ++j) { const uint2 t4 = *(const uint2*)(src + j * 256 + lane * 4);
                  v[q][4 * j] = __uint_as_float(t4.x << 16); v[q][4 * j + 1] = __uint_as_float(t4.x & 0xffff0000u); v[q][4 * j + 2] = __uint_as_float(t4.y << 16); v[q][4 * j + 3] = __uint_as_float(t4.y & 0xffff0000u); } }
#else
              const float* src = (const float*)(p.ws + WS_XB) + (size_t)row * D;
#pragma unroll
              for (int j = 0; j < 4; ++j) { const float4 t4 = *(const float4*)(src + j * 256 + lane * 4); v[q][4 * j] = t4.x; v[q][4 * j + 1] = t4.y; v[q][4 * j + 2] = t4.z; v[q][4 * j + 3] = t4.w; } }
#endif
#pragma unroll
          for (int q = 0; q < 2; ++q) { const int t = 2 * w + q, row = t0 + t;
            if (row < r1) {
                float s = 0.f;
#pragma unroll
                for (int i = 0; i < 16; ++i) s += v[q][i] * v[q][i];
                const float r = rsqrtf(wave_sum(s) * (1.f / D) + EPS);
                const float* modv = (const float*)(p.ws + WS_MOD) + ((size_t)l * 17 + mod_row(row)) * 6 * D + 3 * D;
                bf16* h = (bf16*)(p.ws + WS_H) + (size_t)row * D;
#pragma unroll
                for (int j = 0; j < 4; ++j) { const int c = j * 256 + lane * 4; const float4 g = *(const float4*)(ng + c), sh = *(const float4*)(modv + c), sc = *(const float4*)(modv + D + c);
                    const float o0 = v[q][4 * j] * r * g.x * (1.f + sc.x) + sh.x, o1 = v[q][4 * j + 1] * r * g.y * (1.f + sc.y) + sh.y, o2 = v[q][4 * j + 2] * r * g.z * (1.f + sc.z) + sh.z, o3 = v[q][4 * j + 3] * r * g.w * (1.f + sc.w) + sh.w;
                    *(LAS f32x4*)(hs + t * HST + c) = (f32x4){o0, o1, o2, o3};
                    *(uint2*)(h + c) = make_uint2(cvt_pk_bf16(o0, o1), cvt_pk_bf16(o2, o3)); }
            } else {
#pragma unroll
                for (int j = 0; j < 4; ++j) *(LAS f32x4*)(hs + t * HST + j * 256 + lane * 4) = (f32x4){0.f, 0.f, 0.f, 0.f}; } } }
        __syncthreads();
        { const int e = lane & 31, kh = lane >> 5, kb = 128 * w + 64 * kh; float acc[16];
#pragma unroll
          for (int t = 0; t < 16; ++t) acc[t] = 0.f;
#if RTR_WREG
#pragma unroll
          for (int kk = 0; kk < 64; ++kk) {
#pragma unroll
              for (int t = 0; t < 16; ++t) acc[t] = fmaf(hs[t * HST + kb + kk], rwv[kk], acc[t]); }
#else
#pragma unroll 4
          for (int kk = 0; kk < 64; ++kk) { const float wv = rw[(size_t)(kb + kk) * NEXP + e];
#pragma unroll
              for (int t = 0; t < 16; ++t) acc[t] = fmaf(hs[t * HST + kb + kk], wv, acc[t]); }
#endif
#pragma unroll
          for (int t = 0; t < 16; ++t) red[((w * 2 + kh) * 16 + t) * 32 + e] = acc[t]; }
        __syncthreads();
        { const int t = tid >> 5, e = tid & 31, row = t0 + t; float acc = rb[e];
#pragma unroll
          for (int q = 0; q < 16; ++q) acc += red[(q * 16 + t) * 32 + e];
          float cur = acc, myv = 0.f, mx = 0.f, den = 0.f; int mye = 0;
#pragma unroll
          for (int k = 0; k < 4; ++k) { float bv = cur; int be = e;
#pragma unroll
              for (int o = 1; o < 32; o <<= 1) { const float ov = __shfl_xor(bv, o); const int oe = __shfl_xor(be, o); if (ov > bv || (ov == bv && oe < be)) { bv = ov; be = oe; } }
              if (k == 0) mx = bv;
              const float ex = __expf(bv - mx); den += ex;
              if (e == k) { myv = ex; mye = be; }
              if (e == be) cur = -3.0e38f; }
          if (e < 4 && row < r1) { const int rr = row - r0;
              TE[(size_t)row * 4 + e] = mye; TG[(size_t)row * 4 + e] = myv / den; se[rr * 4 + e] = mye; sp[rr * 4 + e] = (int)__hip_atomic_fetch_add(&hist[mye], 1u, __ATOMIC_RELAXED, __HIP_MEMORY_SCOPE_WORKGROUP); } }
        __syncthreads();
    }
    if (tid < NEXP) base[tid] = atomicAdd(&cnt[tid], hist[tid]);
    __syncthreads();
    int* LIST = (int*)(p.ws + WS_LIST);
    for (int i = tid; i < (r1 - r0) * 4; i += NTHR) { const int row = r0 + (i >> 2); const int e = se[i]; const int pos = sp[i] + (int)base[e];
        TP[(size_t)row * 4 + (i & 3)] = pos; LIST[(size_t)e * NTOK + pos] = row; }
    __syncthreads();
}

typedef float f32x16 __attribute__((ext_vector_type(16)));
struct AttnUnit { int qrow0;
                  int tpos0;
                  int hq;
                  int ctxq;
                  int ctx_row0;
                  int lat_row0;
                  int k0, k1; };
template <int MODE>
__device__ __forceinline__ void attn_unit(const Ptrs& p, int l, LAS unsigned char* lds, const AttnUnit& U, int wave, int lane) {
    constexpr int DK = MODE == 0 ? 96 : 64, NS = DK / 16, KST = DK * 2 + 16, VST = 144, KBUF = 64 * KST, BUF = KBUF + 64 * VST;
    constexpr int KCH = DK / 8;
    constexpr float LOG2E = 1.4426950408889634f;
    const float sc = (MODE == 0 ? 0.10206207261596575f : 0.125f) * LOG2E;
    const int tid = wave * 64 + lane, r = lane & 31, hh = lane >> 5;
    const bf16* Kg; const bf16* Vg; int ldk, ldv;
    if (MODE == 0) { Kg = (const bf16*)(p.ws + WS_KM) + U.hq * 96; ldk = 768; Vg = (const bf16*)(p.ws + WS_VM) + U.hq * 64; ldv = 512; }
    else { Kg = (const bf16*)(p.ws + WS_KS) + (U.hq >> 2) * 64; ldk = 128; Vg = (const bf16*)(p.ws + WS_P) + C_SV + (U.hq >> 2) * 64; ldv = LDP; }
    bf16x8 qf[NS];
    { const bf16* qp = MODE == 0 ? (const bf16*)(p.ws + WS_QM) + (size_t)(U.qrow0 + r) * 768 + U.hq * 96 : (const bf16*)(p.ws + WS_QS) + (size_t)(U.qrow0 + r) * 512 + U.hq * 64;
#pragma unroll
      for (int s = 0; s < NS; ++s) qf[s] = *(const bf16x8*)(qp + 16 * s + 8 * hh);
      const bool rope = MODE == 0 && !U.ctxq;
      const float2* tab = (const float2*)(p.ws + WS_ROPEM) + (size_t)(U.tpos0 + r) * 16 + 8 * hh;
#pragma unroll
      for (int s = 0; s < NS; ++s) { if (rope && s >= NS - 2) continue;
#pragma unroll
          for (int j = 0; j < 8; ++j) qf[s][j] = (short)f2bf(bf2f((bf16)qf[s][j]) * sc); }
      if (rope) {
#pragma unroll
          for (int j = 0; j < 8; ++j) { const float2 cs = tab[j]; const float x1 = bf2f((bf16)qf[NS - 2][j]) * sc, x2 = bf2f((bf16)qf[NS - 1][j]) * sc;
              qf[NS - 2][j] = (short)f2bf(x1 * cs.x - x2 * cs.y); qf[NS - 1][j] = (short)f2bf(x2 * cs.x + x1 * cs.y); } } }
    f32x16 o0, o1;
#pragma unroll
    for (int i = 0; i < 16; ++i) { o0[i] = 0.f; o1[i] = 0.f; }
    f32x16 o2;
#pragma unroll
    for (int i = 0; i < 16; ++i) o2[i] = 0.f;
    float m = 0.f, lsink = MODE == 1 ? __builtin_amdgcn_exp2f(p.sink[l * 8 + U.hq] * LOG2E) : 0.f;
    const bf16x8 ones = {0x3F80, 0x3F80, 0x3F80, 0x3F80, 0x3F80, 0x3F80, 0x3F80, 0x3F80};
    const int nctx = CTXL / 64, nlat = U.ctxq ? 0 : (U.k1 - U.k0) / 64, ntiles = nctx + nlat;
    const int vrow = tid & 63, vch = tid >> 6, vpos = (vrow & ~12) | ((vrow & 4) << 1) | ((vrow & 8) >> 1);
    u32x4 kreg0, kreg1, vreg;
    const bool k2 = (tid + 512) < 64 * KCH;
#define A_TROW(ti) ((ti) < nctx ? U.ctx_row0 + (ti) * 64 : U.lat_row0 + U.k0 + ((ti) - nctx) * 64)
#define A_LOAD(ti) do { const int _tr = A_TROW(ti); \
        { const int c = tid; kreg0 = *(const u32x4*)(Kg + (size_t)(_tr + c / KCH) * ldk + (c % KCH) * 8); } \
        if (k2) { const int c = tid + 512; kreg1 = *(const u32x4*)(Kg + (size_t)(_tr + c / KCH) * ldk + (c % KCH) * 8); } \
        vreg = *(const u32x4*)(Vg + (size_t)(_tr + vrow) * ldv + vch * 8); } while (0)
#define A_STORE(buf) do { LAS unsigned char* kb = lds + (buf) * BUF; \
        { const int c = tid; *(LAS u32x4*)(kb + (c / KCH) * KST + (c % KCH) * 16) = kreg0; } \
        if (k2) { const int c = tid + 512; *(LAS u32x4*)(kb + (c / KCH) * KST + (c % KCH) * 16) = kreg1; } \
        LAS unsigned short* vb = (LAS unsigned short*)(kb + KBUF); const unsigned vv[4] = {vreg.x, vreg.y, vreg.z, vreg.w}; \
        _Pragma("unroll") for (int e = 0; e < 8; ++e) vb[(vch * 8 + e) * (VST / 2) + vpos] = (unsigned short)(e & 1 ? vv[e >> 1] >> 16 : vv[e >> 1] & 0xffffu); } while (0)
    A_LOAD(0); A_STORE(0);
    __syncthreads();
    for (int ti = 0; ti < ntiles; ++ti) {
        if (ti + 1 < ntiles) A_LOAD(ti + 1);
        const LAS unsigned char* kb = lds + (ti & 1) * BUF; const LAS unsigned char* vb = kb + KBUF;
        f32x16 st[2];
        { bf16x8 kf[2][NS];
#pragma unroll
          for (int kt = 0; kt < 2; ++kt)
#pragma unroll
              for (int s = 0; s < NS; ++s) kf[kt][s] = *(const LAS bf16x8*)(kb + (32 * kt + r) * KST + (16 * s + 8 * hh) * 2);
          __builtin_amdgcn_sched_barrier(0);
#pragma unroll
          for (int kt = 0; kt < 2; ++kt) {
#pragma unroll
              for (int i = 0; i < 16; ++i) st[kt][i] = 0.f;
#pragma unroll
              for (int s = 0; s < NS; ++s) st[kt] = __builtin_amdgcn_mfma_f32_32x32x16_bf16(kf[kt][s], qf[s], st[kt], 0, 0, 0); } }
        bf16x8 vf[4][2];
#pragma unroll
        for (int ks = 0; ks < 4; ++ks) { vf[ks][0] = *(const LAS bf16x8*)(vb + r * VST + (16 * ks + 8 * hh) * 2); vf[ks][1] = *(const LAS bf16x8*)(vb + (32 + r) * VST + (16 * ks + 8 * hh) * 2); }
        __builtin_amdgcn_sched_barrier(0);
        float tmax = -1e30f;
#pragma unroll
        for (int kt = 0; kt < 2; ++kt)
#pragma unroll
            for (int i = 0; i < 16; ++i) {
                if (MODE == 1 && ti >= nctx && (ti == nctx || ti == ntiles - 1)) { const int kpos = U.k0 + (ti - nctx) * 64 + 32 * kt + (i & 3) + 8 * (i >> 2) + 4 * hh; const int dlt = kpos - (U.tpos0 + r); if (dlt > 128 || dlt < -128) st[kt][i] = -1e30f; }
                tmax = fmaxf(tmax, st[kt][i]); }
        tmax = fmaxf(tmax, __shfl_xor(tmax, 32));
        if (__any(tmax > m + 60.f)) { const float mn = tmax > m + 60.f ? tmax : m, alpha = __builtin_amdgcn_exp2f(m - mn); m = mn; lsink *= alpha;
#pragma unroll
            for (int i = 0; i < 16; ++i) { o0[i] *= alpha; o1[i] *= alpha; o2[i] *= alpha; } }
        if (__all(m == 0.f)) {
#pragma unroll
            for (int kt = 0; kt < 2; ++kt)
#pragma unroll
                for (int i = 0; i < 16; ++i) st[kt][i] = __builtin_amdgcn_exp2f(st[kt][i]);
        } else {
#pragma unroll
            for (int kt = 0; kt < 2; ++kt)
#pragma unroll
                for (int i = 0; i < 16; ++i) st[kt][i] = __builtin_amdgcn_exp2f(st[kt][i] - m);
        }
#pragma unroll
        for (int ks = 0; ks < 4; ++ks) { u32x4 pw;
            pw.x = cvt_pk_bf16(st[ks >> 1][8 * (ks & 1) + 0], st[ks >> 1][8 * (ks & 1) + 1]); pw.y = cvt_pk_bf16(st[ks >> 1][8 * (ks & 1) + 2], st[ks >> 1][8 * (ks & 1) + 3]);
            pw.z = cvt_pk_bf16(st[ks >> 1][8 * (ks & 1) + 4], st[ks >> 1][8 * (ks & 1) + 5]); pw.w = cvt_pk_bf16(st[ks >> 1][8 * (ks & 1) + 6], st[ks >> 1][8 * (ks & 1) + 7]);
            const bf16x8 pf = __builtin_bit_cast(bf16x8, pw);
            o0 = __builtin_amdgcn_mfma_f32_32x32x16_bf16(vf[ks][0], pf, o0, 0, 0, 0); o1 = __builtin_amdgcn_mfma_f32_32x32x16_bf16(vf[ks][1], pf, o1, 0, 0, 0);
            o2 = __builtin_amdgcn_mfma_f32_32x32x16_bf16(ones, pf, o2, 0, 0, 0); }
        if (ti + 1 < ntiles) A_STORE((ti + 1) & 1);
        __syncthreads();
    }
#undef A_TROW
#undef A_LOAD
#undef A_STORE
    const float inv = 1.f / (o2[0] + lsink);
    bf16* O = (bf16*)(p.ws + WS_BR) + (size_t)(MODE == 0 ? 0 : 1) * NTOK * 512 + (size_t)(U.qrow0 + r) * 512 + U.hq * 64;
#pragma unroll
    for (int g = 0; g < 4; ++g) {
        *(u32x2*)(O + 8 * g + 4 * hh) = (u32x2){cvt_pk_bf16(o0[4 * g] * inv, o0[4 * g + 1] * inv), cvt_pk_bf16(o0[4 * g + 2] * inv, o0[4 * g + 3] * inv)};
        *(u32x2*)(O + 32 + 8 * g + 4 * hh) = (u32x2){cvt_pk_bf16(o1[4 * g] * inv, o1[4 * g + 1] * inv), cvt_pk_bf16(o1[4 * g + 2] * inv, o1[4 * g + 3] * inv)}; }
}
__device__ __forceinline__ void attn_phase(const Ptrs& p, int l, LAS unsigned char* lds, int G, int vcu, int wave, int lane) {
    const int n_ml = NB * 8 * (SEQ / 256), n_sl = NB * 2 * (SEQ / 64), n_mc = l == 0 ? NB * 8 : 0, n_sc = l == 0 ? NB * 2 * (CTXL / 64) : 0;
    for (int u = vcu; u < n_ml; u += G) { const int qb = u & 7, h = (u >> 3) & 7, b = u >> 6;
        AttnUnit U{b * SEQ + qb * 256 + wave * 32, qb * 256 + wave * 32, h, 0, NLAT + b * CTXL, b * SEQ, 0, SEQ}; attn_unit<0>(p, l, lds, U, wave, lane); }
    for (int u = vcu; u < n_sl; u += G) { const int pb = u & 31, kvh = (u >> 5) & 1, b = u >> 6; const int q0 = pb * 64 + (wave & 1) * 32;
        AttnUnit U{b * SEQ + q0, q0, kvh * 4 + (wave >> 1), 0, NLAT + b * CTXL, b * SEQ, max(0, pb * 64 - 128), min(SEQ, pb * 64 + 192)}; attn_unit<1>(p, l, lds, U, wave, lane); }
    for (int u = vcu; u < n_mc; u += G) { const int h = u & 7, b = u >> 3;
        AttnUnit U{NLAT + b * CTXL + wave * 32, 0, h, 1, NLAT + b * CTXL, b * SEQ, 0, 0}; attn_unit<0>(p, l, lds, U, wave, lane); }
    for (int u = vcu; u < n_sc; u += G) { const int pb = u & 3, kvh = (u >> 2) & 1, b = u >> 3; const int q0 = pb * 64 + (wave & 1) * 32;
        AttnUnit U{NLAT + b * CTXL + q0, 0, kvh * 4 + (wave >> 1), 1, NLAT + b * CTXL, b * SEQ, 0, 0}; attn_unit<1>(p, l, lds, U, wave, lane); }
}


constexpr int DN_NCH = (CTXL + SEQ) / 64, DN_REC = 40960;
constexpr size_t WS_GLB = WS_RQ + 768 * 1024;
__device__ __forceinline__ int dn_row(int b, int dir, int ci, int c) {
    if (ci < CTXL / 64) { const int pos = 64 * ci + c; return NLAT + b * CTXL + (dir ? CTXL - 1 - pos : pos); }
    const int pos = 64 * (ci - CTXL / 64) + c; return b * SEQ + (dir ? SEQ - 1 - pos : pos);
}
__device__ __forceinline__ int dn_perm(int col) { return (col & ~31) | (((col >> 2) & 3) << 3) | (((col >> 4) & 1) << 2) | (col & 3); }

__device__ __forceinline__ float rdlane(float v, int i) { return __int_as_float(__builtin_amdgcn_readlane(__float_as_int(v), i)); }
__device__ __forceinline__ void dn_prep_phase(const Ptrs& p, LAS unsigned char* lds, int G, int wave) {
    const int pr = wave & 3, wp = wave >> 2;
    LAS float* Lbuf = (LAS float*)(lds + pr * 32768);
    const bf16* DQ = (const bf16*)(p.ws + WS_DQ); const bf16* DK = (const bf16*)(p.ws + WS_DK); const bf16* DV = (const bf16*)(p.ws + WS_DV);
    for (int chain = blockIdx.x; chain < 256; chain += G) {
        const int b = chain & 15, h = (chain >> 4) & 7, dir = chain >> 7;
        const size_t hb = (size_t)h * 64; const int rs = dir ? -1 : 1;
        for (int rnd = -1; rnd < DN_NCH / 4; ++rnd) {
            const int lane = lane_id(), fr = lane & 15, g4 = lane >> 4;
            if (wp == 1) {
                if (rnd >= 0) {
                    const int ci = rnd * 4 + pr, row0 = dn_row(b, dir, ci, 0), rl = row0 + lane * rs;
                    unsigned char* rec = p.ws + WS_PREP + ((size_t)chain * DN_NCH + ci) * DN_REC; bf16* QD = (bf16*)rec + 4096; bf16* KDT = (bf16*)rec + 3 * 4096;
                    float g = ((const float*)(p.ws + WS_DG))[(size_t)rl * 16 + dir * 8 + h];
                    u32x4 dq4[8], dk4[8];
#pragma unroll
                    for (int rr = 0; rr < 8; ++rr) dq4[rr] = *(const u32x4*)(DQ + (size_t)(row0 + ((lane >> 3) + 8 * rr) * rs) * 512 + hb + 8 * (lane & 7));
#pragma unroll
                    for (int q = 0; q < 8; ++q) dk4[q] = *(const u32x4*)(DK + (size_t)rl * 512 + hb + 8 * q);
#pragma unroll
                    for (int o = 1; o < 64; o <<= 1) { const float t = __shfl_up(g, o); if (lane >= o) g += t; }
                    const float gc = g, egc = __expf(g), gl = rdlane(gc, 63);
#pragma unroll
                    for (int rr = 0; rr < 8; ++rr) { const int i = (lane >> 3) + 8 * rr, cc = lane & 7; const float sc = __shfl(egc, i);
                        float q8[8]; unpack8(dq4[rr], q8);
                        const int p0 = dn_perm(8 * cc), p1 = dn_perm(8 * cc + 4);
                        *(u32x2*)(QD + i * 64 + p0) = (u32x2){cvt_pk_bf16(q8[0] * sc, q8[1] * sc), cvt_pk_bf16(q8[2] * sc, q8[3] * sc)};
                        *(u32x2*)(QD + i * 64 + p1) = (u32x2){cvt_pk_bf16(q8[4] * sc, q8[5] * sc), cvt_pk_bf16(q8[6] * sc, q8[7] * sc)}; }
                    { const float sc = __expf(gl - gc); const int pc = dn_perm(lane);
#pragma unroll
                      for (int q = 0; q < 8; ++q) { float k8[8]; unpack8(dk4[q], k8);
#pragma unroll
                          for (int e = 0; e < 8; ++e) KDT[(8 * q + e) * 64 + pc] = f2bf(k8[e] * sc); } }
                }
                if (rnd + 1 < DN_NCH / 4) {
                    const int ci = (rnd + 1) * 4 + pr, row0 = dn_row(b, dir, ci, 0), rl = row0 + lane * rs;
                    LAS float* Ls = Lbuf + ((rnd + 1) & 1) * 4096;
                    bf16* AI = (bf16*)(p.ws + WS_PREP + ((size_t)chain * DN_NCH + ci) * DN_REC) + 2 * 4096;
                    float g = ((const float*)(p.ws + WS_DG))[(size_t)rl * 16 + dir * 8 + h]; const float bt = ((const float*)(p.ws + WS_DB))[(size_t)rl * 16 + dir * 8 + h];
                    bf16x8 kb[4][2];
#pragma unroll
                    for (int nj = 0; nj < 4; ++nj)
#pragma unroll
                        for (int s = 0; s < 2; ++s) kb[nj][s] = *(const bf16x8*)(DK + (size_t)(row0 + (16 * nj + fr) * rs) * 512 + hb + 32 * s + 8 * g4);
                    bf16x8 qa[4][2];
#pragma unroll
                    for (int mi = 0; mi < 4; ++mi)
#pragma unroll
                        for (int s = 0; s < 2; ++s) qa[mi][s] = *(const bf16x8*)(DQ + (size_t)(row0 + (16 * mi + fr) * rs) * 512 + hb + 32 * s + 8 * g4);
#pragma unroll
                    for (int o = 1; o < 64; o <<= 1) { const float t = __shfl_up(g, o); if (lane >= o) g += t; }
                    const float gc = g;
                    if (lane == 63) ((float*)(p.ws + WS_GLB))[chain * DN_NCH + ci] = __expf(gc);
                    float gcj[4];
#pragma unroll
                    for (int nj = 0; nj < 4; ++nj) gcj[nj] = __shfl(gc, 16 * nj + fr);
#pragma unroll
                    for (int mi = 0; mi < 4; ++mi) {
                        float gci[4], bti[4];
#pragma unroll
                        for (int e = 0; e < 4; ++e) { gci[e] = __shfl(gc, 16 * mi + 4 * g4 + e); bti[e] = __shfl(bt, 16 * mi + 4 * g4 + e); }
#pragma unroll
                        for (int nj = 0; nj < 4; ++nj) { f32x4 kk = {0.f, 0.f, 0.f, 0.f}, qk = {0.f, 0.f, 0.f, 0.f};
#pragma unroll
                            for (int s = 0; s < 2; ++s) { kk = __builtin_amdgcn_mfma_f32_16x16x32_bf16(kb[mi][s], kb[nj][s], kk, 0, 0, 0); qk = __builtin_amdgcn_mfma_f32_16x16x32_bf16(qa[mi][s], kb[nj][s], qk, 0, 0, 0); }
                            const int j = 16 * nj + fr;
#pragma unroll
                            for (int e = 0; e < 4; ++e) { const int i = 16 * mi + 4 * g4 + e; const float dec = __expf(fminf(gci[e] - gcj[nj], 0.f));
                                Ls[i * 64 + j] = i > j ? bti[e] * kk[e] * dec : 0.f;
                                AI[i * 64 + dn_perm(j)] = f2bf(i >= j ? qk[e] * dec : 0.f); } } }
                }
            } else if (rnd >= 0) {
                const int ci = rnd * 4 + pr, row0 = dn_row(b, dir, ci, 0), rl = row0 + lane * rs;
                const LAS float* Ls = Lbuf + (rnd & 1) * 4096;
                unsigned char* rec = p.ws + WS_PREP + ((size_t)chain * DN_NCH + ci) * DN_REC; bf16* NW = (bf16*)rec; bf16* UT = NW + 4 * 4096;
                float g = ((const float*)(p.ws + WS_DG))[(size_t)rl * 16 + dir * 8 + h]; const float bt = ((const float*)(p.ws + WS_DB))[(size_t)rl * 16 + dir * 8 + h];
                float x[64], y[64];
                { const __amdgpu_buffer_rsrc_t rv = __builtin_amdgcn_make_buffer_rsrc((void*)(DV + hb + (size_t)(dir ? row0 - 63 : row0) * 512), 0, 64 * 1024, 0x00020000);
                  const __amdgpu_buffer_rsrc_t rk = __builtin_amdgcn_make_buffer_rsrc((void*)(DK + hb + (size_t)(dir ? row0 - 63 : row0) * 512), 0, 64 * 1024, 0x00020000);
#pragma unroll
                  for (int i = 0; i < 64; ++i) { x[i] = bf2f((bf16)__builtin_amdgcn_raw_buffer_load_b16(rv, lane * 2, (dir ? 63 - i : i) * 1024, 0)); y[i] = bf2f((bf16)__builtin_amdgcn_raw_buffer_load_b16(rk, lane * 2, (dir ? 63 - i : i) * 1024, 0)); } }
#pragma unroll
                for (int o = 1; o < 64; o <<= 1) { const float t = __shfl_up(g, o); if (lane >= o) g += t; }
                { const float scw = bt * __expf(g);
#pragma unroll
                  for (int i = 0; i < 64; ++i) { x[i] *= rdlane(bt, i); y[i] *= rdlane(scw, i); } }
                constexpr int RG = 8, PF = 6;
                f32x4 ring[RG];
                int pi = 1, pj = 0, ps = 0, cs = 0;
#pragma unroll
                for (int k = 0; k < PF; ++k) { ring[ps % RG] = *(const LAS f32x4*)(Ls + pi * 64 + 4 * pj); ++ps; ++pj; if (pj >= (pi + 3) / 4) { ++pi; pj = 0; } }
#pragma unroll
                for (int i = 1; i < 64; ++i) {
                    f32x2 acc4[4] = {{x[i], y[i]}, {0.f, 0.f}, {0.f, 0.f}, {0.f, 0.f}};
#pragma unroll
                    for (int j4 = 0; j4 < (i + 3) / 4; ++j4) {
                        if (pi < 64) { ring[ps % RG] = *(const LAS f32x4*)(Ls + pi * 64 + 4 * pj); ++ps; ++pj; if (pj >= (pi + 3) / 4) { ++pi; pj = 0; } }
                        __builtin_amdgcn_sched_barrier(0);
                        const f32x4 lv = ring[cs % RG]; ++cs;
#pragma unroll
                        for (int e = 0; e < 4; ++e) { const int j = 4 * j4 + e; if (j < i) { const f32x2 l2 = {lv[e], lv[e]}, xy = {x[j], y[j]}; acc4[e] = __builtin_elementwise_fma(-l2, xy, acc4[e]); } } }
                    const f32x2 a2 = (acc4[0] + acc4[1]) + (acc4[2] + acc4[3]); x[i] = a2.x; y[i] = a2.y; }
#pragma unroll
                for (int q = 0; q < 8; ++q) { u32x4 w; w.x = cvt_pk_bf16(x[8 * q], x[8 * q + 1]); w.y = cvt_pk_bf16(x[8 * q + 2], x[8 * q + 3]); w.z = cvt_pk_bf16(x[8 * q + 4], x[8 * q + 5]); w.w = cvt_pk_bf16(x[8 * q + 6], x[8 * q + 7]);
                    *(u32x4*)(UT + lane * 64 + 8 * q) = w; }
                const int pc = dn_perm(lane);
#pragma unroll
                for (int i = 0; i < 64; ++i) NW[i * 64 + pc] = f2bf(-y[i]);
            }
            __syncthreads();
        }
    }
}

__device__ __forceinline__ void dn_scan_phase(const Ptrs& p, int l, LAS unsigned char* lds, int G, int wave) {
    constexpr int MST = 144, MBUF = 64 * MST, BUF = 5 * MBUF;
    const int lane = lane_id(), tid = wave * 64 + lane, fr = lane & 15, g4 = lane >> 4;
    for (int chain = blockIdx.x; chain < 256; chain += G) {
        const int b = chain & 15, h = (chain >> 4) & 7, dir = chain >> 7;
        const unsigned char* rec0 = p.ws + WS_PREP + (size_t)chain * DN_NCH * DN_REC;
        bf16* DO = (bf16*)(p.ws + WS_DO) + (size_t)dir * NTOK * 512 + h * 64 + wave * 16 + fr;
        u32x4 sr[2][5];
#define DN_LOAD(set, ci) do { _Pragma("unroll") for (int i = 0; i < 5; ++i) sr[set][i] = __builtin_nontemporal_load((const u32x4*)(rec0 + (size_t)(ci) * DN_REC + (size_t)(tid + 512 * i) * 16)); } while (0)
#define DN_STORE(set, buf) do { _Pragma("unroll") for (int i = 0; i < 5; ++i) { const int q = tid + 512 * i; *(LAS u32x4*)(lds + (buf) * BUF + (q >> 9) * MBUF + ((q & 511) >> 3) * MST + (q & 7) * 16) = sr[set][i]; } } while (0)
        f32x4 sacc[4];
#pragma unroll
        for (int m = 0; m < 4; ++m) sacc[m] = (f32x4){0.f, 0.f, 0.f, 0.f};
        const float glv = ((const float*)(p.ws + WS_GLB))[chain * DN_NCH + (lane < DN_NCH ? lane : 0)];
        DN_LOAD(0, 0); DN_LOAD(1, 1); DN_STORE(0, 0);
        __syncthreads();
        for (int ci2 = 0; ci2 < DN_NCH; ci2 += 2) {
#pragma unroll
        for (int par = 0; par < 2; ++par) { const int ci = ci2 + par;
            if (ci + 2 < DN_NCH) DN_LOAD(par, ci + 2);
            if (wave < 4) {
                const LAS unsigned char* mb = lds + (ci & 1) * BUF;
                const float gl = rdlane(glv, ci);
#define DN_FRAG(mat, m, s) (*(const LAS bf16x8*)(mb + (mat) * MBUF + (16 * (m) + fr) * MST + (32 * (s) + 8 * g4) * 2))
#define DN_BOP(dst, acc) do { _Pragma("unroll") for (int s = 0; s < 2; ++s) { const unsigned w0 = cvt_pk_bf16(acc[2 * s][0], acc[2 * s][1]), w1 = cvt_pk_bf16(acc[2 * s][2], acc[2 * s][3]), \
                    w2 = cvt_pk_bf16(acc[2 * s + 1][0], acc[2 * s + 1][1]), w3 = cvt_pk_bf16(acc[2 * s + 1][2], acc[2 * s + 1][3]); \
                    dst[s][0] = (short)(w0 & 0xffffu); dst[s][1] = (short)(w0 >> 16); dst[s][2] = (short)(w1 & 0xffffu); dst[s][3] = (short)(w1 >> 16); \
                    dst[s][4] = (short)(w2 & 0xffffu); dst[s][5] = (short)(w2 >> 16); dst[s][6] = (short)(w3 & 0xffffu); dst[s][7] = (short)(w3 >> 16); } } while (0)
                bf16x8 sB[2], vB[2];
                DN_BOP(sB, sacc);
                f32x4 vacc[4], oacc[4];
#pragma unroll
                for (int m = 0; m < 4; ++m) { const u32x2 u = *(const LAS u32x2*)(mb + 4 * MBUF + (wave * 16 + fr) * MST + (16 * m + 4 * g4) * 2);
                    vacc[m] = (f32x4){__uint_as_float(u.x << 16), __uint_as_float(u.x & 0xffff0000u), __uint_as_float(u.y << 16), __uint_as_float(u.y & 0xffff0000u)};
                    oacc[m] = (f32x4){0.f, 0.f, 0.f, 0.f}; }
                { bf16x8 fa[4][2], fb[4][2];
#pragma unroll
                  for (int m = 0; m < 4; ++m)
#pragma unroll
                      for (int s = 0; s < 2; ++s) { fa[m][s] = DN_FRAG(0, m, s); fb[m][s] = DN_FRAG(1, m, s); }
                  __builtin_amdgcn_sched_barrier(0);
#pragma unroll
                  for (int m = 0; m < 4; ++m)
#pragma unroll
                      for (int s = 0; s < 2; ++s) { vacc[m] = __builtin_amdgcn_mfma_f32_16x16x32_bf16(fa[m][s], sB[s], vacc[m], 0, 0, 0);
                          oacc[m] = __builtin_amdgcn_mfma_f32_16x16x32_bf16(fb[m][s], sB[s], oacc[m], 0, 0, 0); }
#pragma unroll
                  for (int m = 0; m < 4; ++m)
#pragma unroll
                      for (int s = 0; s < 2; ++s) { fa[m][s] = DN_FRAG(2, m, s); fb[m][s] = DN_FRAG(3, m, s); }
                  __builtin_amdgcn_sched_barrier(0);
                  DN_BOP(vB, vacc);
#pragma unroll
                  for (int m = 0; m < 4; ++m) { sacc[m] *= gl;
#pragma unroll
                      for (int s = 0; s < 2; ++s) { oacc[m] = __builtin_amdgcn_mfma_f32_16x16x32_bf16(fa[m][s], vB[s], oacc[m], 0, 0, 0);
                          sacc[m] = __builtin_amdgcn_mfma_f32_16x16x32_bf16(fb[m][s], vB[s], sacc[m], 0, 0, 0); } } }
                if (l == 0 || ci >= CTXL / 64) {
#pragma unroll
                    for (int m = 0; m < 4; ++m)
#pragma unroll
                        for (int e = 0; e < 4; ++e) DO[(size_t)dn_row(b, dir, ci, 16 * m + 4 * g4 + e) * 512] = (bf16)(cvt_pk_bf16(oacc[m][e], 0.f) & 0xffffu); }
            }
            if (ci + 1 < DN_NCH) DN_STORE(par ^ 1, par ^ 1);
            __syncthreads();
        } }
#undef DN_LOAD
#undef DN_STORE
#undef DN_FRAG
#undef DN_BOP
    }
}

#ifndef EN_PRO
#define EN_PRO 1
#endif
#ifndef EN_N1
#define EN_N1 1
#endif
#ifndef EN_WIN
#define EN_WIN 1
#endif
#ifndef EN_PREP
#define EN_PREP 1
#endif
#ifndef EN_UP
#define EN_UP 1
#endif
#ifndef EN_MIX
#define EN_MIX 1
#endif
#ifndef EN_DNP
#define EN_DNP 1
#endif
#ifndef EN_MRG
#define EN_MRG 1
#endif
#ifndef EN_WOUT
#define EN_WOUT 1
#endif
#ifndef EN_RTR
#define EN_RTR 1
#endif
#ifndef EN_GU
#define EN_GU 1
#endif
#ifndef EN_DN
#define EN_DN 1
#endif
#ifndef EN_FIN
#define EN_FIN 1
#endif
#ifndef REP_PRO
#define REP_PRO 1
#endif
#ifndef REP_N1
#define REP_N1 1
#endif
#ifndef REP_WIN
#define REP_WIN 1
#endif
#ifndef REP_PREP
#define REP_PREP 1
#endif
#ifndef REP_UP
#define REP_UP 1
#endif
#ifndef REP_MIX
#define REP_MIX 1
#endif
#ifndef REP_DNP
#define REP_DNP 1
#endif
#ifndef REP_MRG
#define REP_MRG 1
#endif
#ifndef REP_WOUT
#define REP_WOUT 1
#endif
#ifndef REP_RTR
#define REP_RTR 1
#endif
#ifndef REP_GU
#define REP_GU 1
#endif
#ifndef REP_DN
#define REP_DN 1
#endif
#ifndef REP_FIN
#define REP_FIN 1
#endif
#ifndef WIN_TAILU
#define WIN_TAILU 448
#endif
#ifndef WIN_NCV
#define WIN_NCV 64
#endif
#ifndef REP_SCAN
#define REP_SCAN 1
#endif
#ifndef REP_ATTN
#define REP_ATTN 1
#endif
#ifndef REP_DNPREP
#define REP_DNPREP 1
#endif
#ifndef DN_CHUNKED
#define DN_CHUNKED 1
#endif
#ifndef CTX_KV_ONLY
#define CTX_KV_ONLY 1
#endif
#ifndef MIX_SWAP
#define MIX_SWAP 2
#endif
#ifndef MIX_VALU
#define MIX_VALU 0
#endif
constexpr int NPH_L = 11, PH_FINAL = 1 + 2 * NPH_L, NPHASES = PH_FINAL + 1;
struct Args { Ptrs p; int ph_lo, ph_hi, bar_idx, pad; };

__global__ void __launch_bounds__(NTHR, 2) fwd(Args args) {
    extern __shared__ __attribute__((aligned(16))) unsigned char lds_raw[];
    LAS unsigned char* lds = (LAS unsigned char*)lds_raw;
#if defined(__HIP_DEVICE_COMPILE__)
#define PH_PTRS() const __attribute__((address_space(4))) Ptrs* _pk = (const __attribute__((address_space(4))) Ptrs*)__builtin_amdgcn_kernarg_segment_ptr(); asm volatile("" : "+s"(_pk)); const Ptrs p = *_pk
#else
#define PH_PTRS() const Ptrs p = args.p
#endif
    const int wave = __builtin_amdgcn_readfirstlane(threadIdx.x >> 6);
    const int G = gridDim.x, gw = blockIdx.x * NWAVES + wave, NGW = G * NWAVES;
    const int vcu = (G % 8 == 0) ? (int)(blockIdx.x % 8) * (G / 8) + (int)(blockIdx.x / 8) : (int)blockIdx.x;
    volatile LAS unsigned* MISC = (volatile LAS unsigned*)(lds + LDS_MISC_OFF);
    LAS int* TAB = (LAS int*)(lds + LDS_TAB_OFF);
    if (threadIdx.x < 256) MISC[threadIdx.x] = 0u;
    __syncthreads();
    XcdBarrier bar = xcd_barrier_post((unsigned*)(args.p.ws + WS_CTL) + CW_BAR + args.bar_idx * XCD_BAR_WORDS, MISC + 8);
    const int lo = args.ph_lo, hi = args.ph_hi;
#define IN(k) (lo <= (k) && (k) < hi)
#ifndef REP_BAR
#define REP_BAR 1
#endif
#define SEAM(k) do { if (IN(k) && IN((k) + 1)) for (int _rb = 0; _rb < REP_BAR; ++_rb) xcd_barrier(bar, wave); } while (0)

    if (EN_PRO && IN(0)) for (int _rep = 0; _rep < REP_PRO; ++_rep) { if (_rep) __syncthreads(); PH_PTRS();
        mod_phase(p, (LAS float*)lds, G, wave);
        const int lane = lane_id();
        rope_tables(p, blockIdx.x * NTHR + wave * 64 + lane, G * NTHR);
        conv_dense_weights(p, (LAS float*)(lds + wave * 16384), gw, NGW, lane);
    }
    SEAM(0);
    for (int l = 0; l < 2; ++l) {
        const int pb = 1 + NPH_L * l, nq = l == 0 ? NTOK : NLAT;
        if (EN_N1 && IN(pb + 0)) for (int _rep = 0; _rep < REP_N1; ++_rep) { if (_rep) __syncthreads(); PH_PTRS();
            const int lane = lane_id();
            if (l > 0) moe_tables(TAB, TAB + 64, (const unsigned*)(p.ws + WS_CTL) + CW_CNT + 32 * (l - 1), 1, wave);
            for (int row = gw; row < NTOK; row += 2 * NGW) norm1_rows2(p, l, 0, row, row + NGW < NTOK ? row + NGW : -1, lane, TAB + 64);
        }
        SEAM(pb + 0);
        if (EN_WIN && IN(pb + 1)) for (int _rep = 0; _rep < REP_WIN; ++_rep) { if (_rep) __syncthreads(); PH_PTRS();
            const int ncv = (G >= 64 && G % 8 == 0) ? WIN_NCV : 0;
            const int xtra = (CTX_KV_ONLY && l == 1) ? (NCTX / BM) * 11 : 0, mrows = xtra ? NLAT : NTOK;
            const int nunits = (mrows / BM) * (LDP / BM) + xtra, ntail = ncv ? WIN_TAILU : 0;
            const bool cvt = (int)blockIdx.x >= G - ncv;
            if (cvt) { conv_moe_weights(p, l, (LAS float*)(lds + wave * 16384), ((int)blockIdx.x - (G - ncv)) * NWAVES + wave, ncv * NWAVES, lane_id()); __syncthreads(); }
            { DenseSched S; S.init(p.ws + WS_H, D * 2, p.ws + WS_WIN + (size_t)l * LDP * D * 2, D, mrows, LDP, cvt ? ncv : G - ncv, cvt ? (int)blockIdx.x - (G - ncv) : (int)blockIdx.x);
              S.xtra = xtra;
              if (cvt) S.L0 = nunits - ntail; else S.L1 = nunits - ntail;
              EpiWin E{(bf16*)(p.ws + WS_P)};
              gemm_phase<EpiWin, DenseSched, false>(lds, D, D * 2, S, E, wave); }
            if (ncv == 0) conv_moe_weights(p, l, (LAS float*)(lds + wave * 16384), gw, NGW, lane_id());
        }
        SEAM(pb + 1);
        if (EN_PREP && IN(pb + 2)) for (int _rep = 0; _rep < REP_PREP; ++_rep) { if (_rep) __syncthreads(); PH_PTRS(); prep_phase2(p, l, gw, NGW, lane_id()); }
        SEAM(pb + 2);
        if (EN_UP && IN(pb + 3)) for (int _rep = 0; _rep < REP_UP; ++_rep) { if (_rep) __syncthreads(); PH_PTRS();
            { DenseSched S; S.init(p.ws + WS_P + C_CQ * 2, LDP * 2, p.ws + WS_WQUP + (size_t)l * 768 * 384 * 2, 384, NTOK, 768, G, blockIdx.x);
              EpiQup E{(bf16*)(p.ws + WS_QM), (const float*)(p.ws + WS_RQ)};
              gemm_phase<EpiQup, DenseSched, false>(lds, 384, LDP * 2, S, E, wave); }
            { const int kvc = ((int)blockIdx.x + ((G - (NTOK / BM * 3) % G) / 8) * 8) % G;
              DenseSched S; S.init(p.ws + WS_P + C_CKV * 2, LDP * 2, p.ws + WS_WKVUP + (size_t)l * 1024 * 256 * 2, 256, NTOK, 1024, G, kvc);
              EpiKVup E{(bf16*)(p.ws + WS_KM), (bf16*)(p.ws + WS_VM), (const float*)(p.ws + WS_RKV)};
              gemm_phase<EpiKVup, DenseSched, false>(lds, 256, LDP * 2, S, E, wave); }
#if DN_CHUNKED
            for (int _r2 = 0; _r2 < REP_DNPREP; ++_r2) dn_prep_phase(p, lds, G, wave);
#endif
        }
        SEAM(pb + 3);
        if (EN_MIX && IN(pb + 4)) for (int _rep = 0; _rep < REP_MIX; ++_rep) { if (_rep) __syncthreads(); PH_PTRS();
#if MIX_VALU
            mixers_valu_phase(p, l, lds, gw, NGW, wave, lane_id());
#else
#if DN_CHUNKED
#if MIX_SWAP
            { int par = MIX_SWAP == 2 ? ((int)blockIdx.x & 1) : MIX_SWAP == 3 ? (vcu & 1) : (vcu >> 3) & 1; asm volatile("" : "+s"(par));
#pragma unroll 1
              for (int s_ = 0; s_ < 2; ++s_) { if ((s_ ^ par) == 0) dn_scan_phase(p, l, lds, G, wave); else attn_phase(p, l, lds, G, vcu, wave, lane_id()); __syncthreads(); } }
#else
            for (int _r2 = 0; _r2 < REP_SCAN; ++_r2) dn_scan_phase(p, l, lds, G, wave);
#endif
#else
            { const int lane = lane_id(); for (int r = gw; r < 256; r += NGW) dn_scan_wave(p, r & 15, (r >> 4) & 7, r >> 7, (LAS float*)(lds + wave * 16384), lane); }
            __syncthreads();
#endif
#if !MIX_SWAP
            for (int _r2 = 0; _r2 < REP_ATTN; ++_r2) attn_phase(p, l, lds, G, vcu, wave, lane_id());
#endif
#endif
        }
        SEAM(pb + 4);
        if (EN_DNP && IN(pb + 5)) for (int _rep = 0; _rep < REP_DNP; ++_rep) { if (_rep) __syncthreads(); PH_PTRS(); const int lane = lane_id(); for (int row = gw; row < nq; row += NGW) dnpost_row(p, l, row, lane); }
        SEAM(pb + 5);
        if (EN_MRG && IN(pb + 6)) for (int _rep = 0; _rep < REP_MRG; ++_rep) { if (_rep) __syncthreads(); PH_PTRS();
            MergeSched S{(const char*)(p.ws + WS_BR), (const char*)(p.ws + WS_WBR + (size_t)l * 3072 * 512 * 2), nq / BM, G, (int)blockIdx.x, (size_t)NTOK * 512 * 2};
            EpiMerge E{(bf16*)(p.ws + WS_YB), (const bf16*)(p.ws + WS_P)};
            gemm_phase<EpiMerge, MergeSched, false>(lds, 512, 512 * 2, S, E, wave);
        }
        SEAM(pb + 6);
        if (EN_WOUT && IN(pb + 7)) for (int _rep = 0; _rep < REP_WOUT; ++_rep) { if (_rep) __syncthreads(); PH_PTRS();
            DenseSched S; S.init(p.ws + WS_YB, D * 2, p.ws + WS_WOUT + (size_t)l * D * D * 2, D, nq, D, G, blockIdx.x);
            EpiWout E{p, l};
            gemm_phase<EpiWout, DenseSched, false>(lds, D, D * 2, S, E, wave);
        }
        SEAM(pb + 7);
        if (EN_RTR && IN(pb + 8)) for (int _rep = 0; _rep < REP_RTR; ++_rep) { if (_rep) __syncthreads(); PH_PTRS(); router_phase2(p, l, nq, lds, G, wave); }
        SEAM(pb + 8);
        if (EN_GU && IN(pb + 9)) for (int _rep = 0; _rep < REP_GU; ++_rep) { if (_rep) __syncthreads(); PH_PTRS();
            const unsigned* cnt = (const unsigned*)(p.ws + WS_CTL) + CW_CNT + 32 * l;
            moe_tables(TAB, TAB + 64, cnt, 8, wave);
            MoeSched S{TAB, TAB + 64, cnt, (const char*)(p.ws + WS_H), (const char*)(p.ws + WS_WGU), (const int*)(p.ws + WS_LIST), 8, G, vcu, D, 1, D * 2};
            EpiGu E{(bf16*)(p.ws + WS_ACT), p.b_gu + (size_t)l * NEXP * 2 * DEXP};
            gemm_phase<EpiGu, MoeSched, true>(lds, D, D * 2, S, E, wave);
        }
        SEAM(pb + 9);
        if (EN_DN && IN(pb + 10)) for (int _rep = 0; _rep < REP_DN; ++_rep) { if (_rep) __syncthreads(); PH_PTRS();
            const unsigned* cnt = (const unsigned*)(p.ws + WS_CTL) + CW_CNT + 32 * l;
            moe_tables(TAB, TAB + 64, cnt, 4, wave);
            MoeSched S{TAB, TAB + 64, cnt, (const char*)(p.ws + WS_ACT), (const char*)(p.ws + WS_WDN), nullptr, 4, G, vcu, DEXP, 0, DEXP * 2};
            EpiDn E{(bf16*)(p.ws + WS_YM), p.b_dn + (size_t)l * NEXP * D};
            gemm_phase<EpiDn, MoeSched, false>(lds, DEXP, DEXP * 2, S, E, wave);
        }
        SEAM(pb + 10);
    }
    if (EN_FIN && IN(PH_FINAL)) for (int _rep = 0; _rep < REP_FIN; ++_rep) { if (_rep) __syncthreads(); PH_PTRS();
        const int lane = lane_id();
        moe_tables(TAB, TAB + 64, (const unsigned*)(p.ws + WS_CTL) + CW_CNT + 32, 1, wave);
        for (int row = gw; row < NLAT; row += 2 * NGW) norm1_rows2(p, 2, 2, row, row + NGW < NLAT ? row + NGW : -1, lane, TAB + 64);
    }
#undef IN
#undef SEAM
}

#ifndef MEGA_MASK
#define MEGA_MASK 0x1fff
#endif
static int phase_kind(int ph) { if (ph == 0) return 0; if (ph == PH_FINAL) return 12; return 1 + (ph - 1) % NPH_L; }
static void simple_phase(const Ptrs& p, hipStream_t st, int ph) {
    unsigned char* ws = p.ws;
    if (ph == 0) { hipLaunchKernelGGL(k_mod, dim3(6 * D / 256, 17, 2), dim3(256), 0, st, p); return; }
    if (ph == PH_FINAL) { hipLaunchKernelGGL(k_norm1, dim3(NLAT / 4), dim3(256), 0, st, p, 2, NLAT, 2); return; }
    const int l = (ph - 1) / NPH_L, k = (ph - 1) % NPH_L, nq = l == 0 ? NTOK : NLAT;
    switch (k) {
    case 0: hipLaunchKernelGGL(k_norm1, dim3(NTOK / 4), dim3(256), 0, st, p, l, NTOK, 0); break;
    case 1: run_sgemm(st, NTOK, DIN, D, ABf{(const bf16*)(ws + WS_H), D, 0}, WF32{p.w_in + (size_t)l * D * DIN, DIN, 0}, EStoreBf{(bf16*)(ws + WS_P), LDP, 0}); break;
    case 2: hipLaunchKernelGGL(k_prep, dim3(NTOK / 4), dim3(256), 0, st, p, l); break;
    case 3:
        run_sgemm(st, NTOK, 768, 384, ABfG{(const bf16*)(ws + WS_P) + C_CQ, p.q_norm_g + l * 384, LDP, 0}, WF32{p.w_q_up + (size_t)l * 384 * 768, 768, 0}, EQup{(bf16*)(ws + WS_QM), (const float*)(ws + WS_RQ)});
        run_sgemm(st, NTOK, 1024, 256, ABfG{(const bf16*)(ws + WS_P) + C_CKV, p.kv_norm_g + l * 256, LDP, 0}, WF32{p.w_kv_up + (size_t)l * 256 * 1024, 1024, 0},
                  EKVup{(bf16*)(ws + WS_KM), (bf16*)(ws + WS_VM), (const float*)(ws + WS_RKV)});
        break;
    case 4:
        hipLaunchKernelGGL((k_attn<96, 0>), dim3(SEQ / 64, 8, NB), dim3(64), 0, st, p, l, 0);
        if (l == 0) hipLaunchKernelGGL((k_attn<96, 0>), dim3(CTXL / 64, 8, NB), dim3(64), 0, st, p, l, 1);
        hipLaunchKernelGGL((k_attn<64, 1>), dim3(SEQ / 64, 8, NB), dim3(64), 0, st, p, l, 0);
        if (l == 0) hipLaunchKernelGGL((k_attn<64, 1>), dim3(CTXL / 64, 8, NB), dim3(64), 0, st, p, l, 1);
        hipLaunchKernelGGL(k_dn_scan, dim3(NB, 8, 2), dim3(64), 0, st, p);
        break;
    case 5: hipLaunchKernelGGL(k_dn_post, dim3(nq / 4), dim3(256), 0, st, p, l, nq); break;
    case 6:
        for (int i = 0; i < 3; ++i)
            run_sgemm(st, nq, D, 512, ABf{(const bf16*)(ws + WS_BR) + (size_t)i * NTOK * 512, 512, 0}, WF32{p.w_branch + ((size_t)l * 3 + i) * 512 * D, D, 0},
                      EMerge{(float*)(ws + WS_YF), (bf16*)(ws + WS_YB), (const bf16*)(ws + WS_P), i, 0});
        break;
    case 7: run_sgemm(st, nq, D, D, ABf{(const bf16*)(ws + WS_YB), D, 0}, WF32{p.w_out + (size_t)l * D * D, D, 0}, EWout{p, l, 0}); break;
    case 8: hipLaunchKernelGGL(k_norm2_router, dim3(nq / R2_ROWS), dim3(256), 0, st, p, l, nq); break;
    case 9: hipLaunchKernelGGL(k_moe_gu, dim3(2 * DEXP / 128, NTOK * 4 / 128 + NEXP), dim3(256), 0, st, p, l); break;
    case 10: hipLaunchKernelGGL(k_moe_dn, dim3(D / 128, NTOK * 4 / 128 + NEXP), dim3(256), 0, st, p, l); break;
    }
}
extern "C" void kernel_launch(void* const* d_in, const int* in_sizes, int n_in, void* d_out, int out_size, void* d_ws, size_t ws_size, hipStream_t stream) {
    static int grid = 0;
    if (grid == 0) {
        if (n_in != 27 || ws_size < WS_END2) { fprintf(stderr, "kernel_launch: unexpected n_in %d / ws %zu (need %zu)\n", n_in, ws_size, (size_t)WS_END2); grid = -1; return; }
        int dev = 0, cus = 0, per_cu = 0;
        if (hipGetDevice(&dev) != hipSuccess || hipDeviceGetAttribute(&cus, hipDeviceAttributeMultiprocessorCount, dev) != hipSuccess) { grid = -1; return; }
        if (hipFuncSetAttribute((const void*)fwd, hipFuncAttributeMaxDynamicSharedMemorySize, LDS_BYTES) != hipSuccess) { fprintf(stderr, "kernel_launch: hipFuncSetAttribute failed\n"); grid = -1; return; }
        if (hipOccupancyMaxActiveBlocksPerMultiprocessor(&per_cu, (const void*)fwd, NTHR, LDS_BYTES) != hipSuccess || per_cu < 1) { fprintf(stderr, "kernel_launch: occupancy query says %d\n", per_cu); }
        (void)hipGetLastError();
        grid = cus;
    }
    if (grid < 0) return;
    const Ptrs p = make_ptrs(d_in, d_out, d_ws);
    (void)hipMemsetAsync((char*)d_ws + WS_CTL, 0, CTL_BYTES, stream);
    int bar_idx = 0;
    bool need_pro = false;
    for (int k = 1; k < 13; ++k) if ((MEGA_MASK >> k) & 1) need_pro = true;
    for (int ph = 0; ph < NPHASES;) {
        const int kind = phase_kind(ph);
        const bool mega = ((MEGA_MASK >> kind) & 1) || (ph == 0 && need_pro);
        if (!mega) { simple_phase(p, stream, ph); ++ph; continue; }
        int hi = ph + 1;
        while (hi < NPHASES && ((MEGA_MASK >> phase_kind(hi)) & 1)) ++hi;
        Args a{}; a.p = p; a.ph_lo = ph; a.ph_hi = hi; a.bar_idx = bar_idx++; a.pad = 0;
        hipLaunchKernelGGL(fwd, dim3(grid), dim3(NTHR), LDS_BYTES, stream, a);
        if (ph == 0 && !((MEGA_MASK >> 0) & 1)) simple_phase(p, stream, 0);
        ph = hi;
    }
}
```
